# Optimizing an MI355X kernel written in HIP

```python
import math
import jax, jax.numpy as jnp
from jax import lax
import numpy as np

D_MODEL = 2048
BATCH = 4
SEQ = 2048
DEPTH = 1
DEC_BATCH = 128
DEC_SEQ = 4
PAST_LEN = 16384
PAGE_SIZE = 128

D_MIX = D_MODEL
D_POOL = D_MIX // 2
D_SSM = D_MIX - D_POOL
POOL_WINDOWS = (2, 4, 8, 16)
N_POOL_GROUPS = len(POOL_WINDOWS)
POOL_GROUP_DIM = D_POOL // N_POOL_GROUPS
POOL_BUF = max(POOL_WINDOWS) - 1
SSM_GROUP_CH = 16
N_SSM_GROUPS = D_SSM // SSM_GROUP_CH
SSM_STATE = 64
N_MEM = 256
N_XHEADS = 4
XHEAD_DIM = D_MODEL // N_XHEADS
D_FF = 5632
CONV_W = 3
CONV_BUF = CONV_W - 1
ALPHA = (2.0 * DEPTH) ** 0.25
BETA = (8.0 * DEPTH) ** -0.25
LN_EPS = 1e-5

kernel_name = "hymba_pool_s5_memxattn_convffn_step"


def layer_norm(x, g, b):
    xf = x.astype(jnp.float32)
    mu = jnp.mean(xf, axis=-1, keepdims=True)
    var = jnp.mean(jnp.square(xf - mu), axis=-1, keepdims=True)
    y = (xf - mu) * lax.rsqrt(var + LN_EPS) * g.astype(jnp.float32) + b.astype(jnp.float32)
    return y.astype(x.dtype)


def pool_mixer(u, buf, pos0, w_pool, pool_scale):
    nb, t, _ = u.shape
    ext = jnp.concatenate([buf.astype(u.dtype), u], axis=1)
    cs = jnp.cumsum(ext.astype(jnp.float32), axis=1)
    cs = jnp.pad(cs, ((0, 0), (1, 0), (0, 0)))
    end = cs[:, POOL_BUF + 1:POOL_BUF + 1 + t]
    pos = pos0 + jnp.arange(t, dtype=jnp.int32)
    outs = []
    for g, w in enumerate(POOL_WINDOWS):
        sl = slice(g * POOL_GROUP_DIM, (g + 1) * POOL_GROUP_DIM)
        start = cs[:, POOL_BUF + 1 - w:POOL_BUF + 1 - w + t, sl]
        cnt = jnp.minimum(pos + 1, w).astype(jnp.float32)[None, :, None]
        outs.append((end[..., sl] - start) / cnt)
    pooled = jnp.concatenate(outs, axis=-1) - u.astype(jnp.float32)
    pooled = pooled.astype(u.dtype).reshape(nb, t, N_POOL_GROUPS, POOL_GROUP_DIM)
    mixed = jnp.einsum('btgc,gcd->btgd', pooled, w_pool).reshape(nb, t, D_POOL)
    return mixed * pool_scale, ext[:, -POOL_BUF:]


def _ssm_combine(e1, e2):
    a1, b1 = e1
    a2, b2 = e2
    return a1 * a2, a2 * b1 + b2


def ssm_mixer(u, h0_re, h0_im, lambda_re, lambda_im, log_step, b_re, b_im, c_re, c_im, d_skip, w_glu, b_glu):
    f32 = jnp.float32
    nb, t, _ = u.shape
    uf = u.astype(f32).reshape(nb, t, N_SSM_GROUPS, SSM_GROUP_CH)
    lam = lax.complex(lambda_re.astype(f32), lambda_im.astype(f32))
    dt = jnp.exp(log_step.astype(f32))[:, None]
    lam_bar = jnp.exp(lam * dt)
    b_bar = ((lam_bar - 1.0) / lam)[:, :, None] * lax.complex(b_re.astype(f32), b_im.astype(f32))
    c = lax.complex(c_re.astype(f32), c_im.astype(f32))
    bu = jnp.einsum('gnc,btgc->btgn', b_bar, uf.astype(jnp.complex64))
    h0 = lax.complex(h0_re.astype(f32), h0_im.astype(f32))
    bu = bu.at[:, 0].add(lam_bar[None] * h0)
    a = jnp.broadcast_to(lam_bar, bu.shape)
    _, h = lax.associative_scan(_ssm_combine, (a, bu), axis=1)
    y = jnp.real(jnp.einsum('gcn,btgn->btgc', c, h)) + d_skip.astype(f32).reshape(N_SSM_GROUPS, SSM_GROUP_CH) * uf
    z = jax.nn.gelu(y.reshape(nb, t, D_SSM)).astype(u.dtype)
    out = z * jax.nn.sigmoid(z @ w_glu + b_glu)
    h_last = h[:, -1]
    return out, jnp.real(h_last).astype(h0_re.dtype), jnp.imag(h_last).astype(h0_re.dtype)


def mem_kv(mem, w_k, w_v):
    nb = mem.shape[0]
    k = (mem @ w_k).reshape(nb, N_MEM, N_XHEADS, XHEAD_DIM)
    v = (mem @ w_v).reshape(nb, N_MEM, N_XHEADS, XHEAD_DIM)
    return k, v


def cross_attn(h, k, v, w_q, w_o):
    nb, t, _ = h.shape
    q = (h @ w_q).reshape(nb, t, N_XHEADS, XHEAD_DIM)
    s = jnp.einsum('bthd,bmhd->bhtm', q, k).astype(jnp.float32) * (XHEAD_DIM ** -0.5)
    p = jax.nn.softmax(s, axis=-1).astype(v.dtype)
    o = jnp.einsum('bhtm,bmhd->bthd', p, v).reshape(nb, t, N_XHEADS * XHEAD_DIM)
    return o @ w_o


def conv_ffn(h, buf, w_gate, w_up, conv_w, conv_b, w_down):
    t = h.shape[1]
    g = h @ w_gate
    ext = jnp.concatenate([buf.astype(g.dtype), g], axis=1)
    gc = conv_b + ext[:, 0:t] * conv_w[0]
    for k in range(1, CONV_W):
        gc = gc + ext[:, k:k + t] * conv_w[k]
    out = (jax.nn.silu(gc) * (h @ w_up)) @ w_down
    return out, ext[:, -CONV_BUF:]


def layer(x, mk, mv, pool_buf, pos0, h0_re, h0_im, conv_buf,
          w_in, w_pool, pool_scale, lambda_re, lambda_im, log_step, b_re, b_im, c_re, c_im,
          d_skip, w_glu, b_glu, w_out, ln1_g, ln1_b, w_q, w_o, ln2_g, ln2_b,
          w_gate, w_up, conv_w, conv_b, w_down, ln3_g, ln3_b):
    u = x @ w_in
    a_out, new_pool = pool_mixer(u[..., :D_POOL], pool_buf, pos0, w_pool, pool_scale)
    b_out, new_re, new_im = ssm_mixer(u[..., D_POOL:], h0_re, h0_im, lambda_re, lambda_im, log_step,
                                      b_re, b_im, c_re, c_im, d_skip, w_glu, b_glu)
    mix = jnp.concatenate([a_out, b_out], axis=-1) @ w_out
    h = layer_norm(ALPHA * x + mix, ln1_g, ln1_b)
    h = layer_norm(ALPHA * h + cross_attn(h, mk, mv, w_q, w_o), ln2_g, ln2_b)
    f, new_conv = conv_ffn(h, conv_buf, w_gate, w_up, conv_w, conv_b, w_down)
    y = layer_norm(ALPHA * h + f, ln3_g, ln3_b)
    return y, new_pool, new_re, new_im, new_conv


def setup_inputs(seed: int = 0) -> dict:
    key = jax.random.key(seed)
    ks = iter(jax.random.split(key, 48))
    f32 = jnp.float32
    L, G, N, C = DEPTH, N_SSM_GROUPS, SSM_STATE, SSM_GROUP_CH

    def nrm(shape, scale):
        return jax.random.normal(next(ks), shape, f32) * scale

    def gain(shape):
        return 1.0 + nrm(shape, 0.05)

    x_prompt = nrm((BATCH, SEQ, D_MODEL), 1.0)
    x_sample = nrm((DEC_BATCH, DEC_SEQ, D_MODEL), 1.0)
    mem_prompt = nrm((BATCH, N_MEM, D_MODEL), 1.0)
    state_pool = nrm((L, DEC_BATCH, POOL_BUF, D_POOL), 1.0)
    state_ssm_re = nrm((L, DEC_BATCH, G, N), 0.2)
    state_ssm_im = nrm((L, DEC_BATCH, G, N), 0.2)
    state_conv = nrm((L, DEC_BATCH, CONV_BUF, D_FF), 1.0)
    cache_mem_k = nrm((L, DEC_BATCH, N_MEM, N_XHEADS, XHEAD_DIM), 1.0)
    cache_mem_v = nrm((L, DEC_BATCH, N_MEM, N_XHEADS, XHEAD_DIM), BETA)

    w_in = nrm((L, D_MODEL, D_MIX), D_MODEL ** -0.5)
    w_pool = nrm((L, N_POOL_GROUPS, POOL_GROUP_DIM, POOL_GROUP_DIM), POOL_GROUP_DIM ** -0.5)
    pool_scale = gain((L, D_POOL))
    lambda_re = -0.5 + nrm((L, G, N), 0.01)
    lambda_im = math.pi * jnp.broadcast_to(jnp.arange(N, dtype=f32), (L, G, N)) + nrm((L, G, N), 0.01)
    log_step = jax.random.uniform(next(ks), (L, G), f32, math.log(1e-3), math.log(1e-1))
    b_re = nrm((L, G, N, C), (2.0 * C) ** -0.5)
    b_im = nrm((L, G, N, C), (2.0 * C) ** -0.5)
    c_re = nrm((L, G, C, N), (2.0 * N) ** -0.5)
    c_im = nrm((L, G, C, N), (2.0 * N) ** -0.5)
    d_skip = nrm((L, D_SSM), 1.0)
    w_glu = nrm((L, D_SSM, D_SSM), D_SSM ** -0.5)
    b_glu = nrm((L, D_SSM), 0.01)
    w_out = nrm((L, D_MIX, D_MODEL), BETA * D_MIX ** -0.5)
    ln1_g = gain((L, D_MODEL))
    ln1_b = nrm((L, D_MODEL), 0.01)
    w_q = nrm((L, D_MODEL, N_XHEADS * XHEAD_DIM), D_MODEL ** -0.5)
    w_k = nrm((L, D_MODEL, N_XHEADS * XHEAD_DIM), D_MODEL ** -0.5)
    w_v = nrm((L, D_MODEL, N_XHEADS * XHEAD_DIM), BETA * D_MODEL ** -0.5)
    w_o = nrm((L, N_XHEADS * XHEAD_DIM, D_MODEL), BETA * D_MODEL ** -0.5)
    ln2_g = gain((L, D_MODEL))
    ln2_b = nrm((L, D_MODEL), 0.01)
    w_gate = nrm((L, D_MODEL, D_FF), D_MODEL ** -0.5)
    w_up = nrm((L, D_MODEL, D_FF), D_MODEL ** -0.5)
    conv_w = nrm((L, CONV_W, D_FF), CONV_W ** -0.5)
    conv_b = nrm((L, D_FF), 0.01)
    w_down = nrm((L, D_FF, D_MODEL), BETA * D_FF ** -0.5)
    ln3_g = gain((L, D_MODEL))
    ln3_b = nrm((L, D_MODEL), 0.01)
    return {
        "x_prompt": x_prompt, "x_sample": x_sample, "mem_prompt": mem_prompt,
        "state_pool": state_pool, "state_ssm_re": state_ssm_re, "state_ssm_im": state_ssm_im,
        "state_conv": state_conv, "cache_mem_k": cache_mem_k, "cache_mem_v": cache_mem_v,
        "w_in": w_in, "w_pool": w_pool, "pool_scale": pool_scale,
        "lambda_re": lambda_re, "lambda_im": lambda_im, "log_step": log_step,
        "b_re": b_re, "b_im": b_im, "c_re": c_re, "c_im": c_im, "d_skip": d_skip,
        "w_glu": w_glu, "b_glu": b_glu, "w_out": w_out, "ln1_g": ln1_g, "ln1_b": ln1_b,
        "w_q": w_q, "w_k": w_k, "w_v": w_v, "w_o": w_o, "ln2_g": ln2_g, "ln2_b": ln2_b,
        "w_gate": w_gate, "w_up": w_up, "conv_w": conv_w, "conv_b": conv_b, "w_down": w_down,
        "ln3_g": ln3_g, "ln3_b": ln3_b,
    }


def reference(x_prompt, x_sample, mem_prompt, state_pool, state_ssm_re, state_ssm_im, state_conv,
              cache_mem_k, cache_mem_v, w_in, w_pool, pool_scale, lambda_re, lambda_im, log_step,
              b_re, b_im, c_re, c_im, d_skip, w_glu, b_glu, w_out, ln1_g, ln1_b,
              w_q, w_k, w_v, w_o, ln2_g, ln2_b, w_gate, w_up, conv_w, conv_b, w_down, ln3_g, ln3_b):
    yp, ys = x_prompt, x_sample
    nbp = x_prompt.shape[0]
    p_pool, p_re, p_im, p_conv, p_mk, p_mv = [], [], [], [], [], []
    s_pool, s_re, s_im, s_conv = [], [], [], []
    for l in range(DEPTH):
        prm = dict(w_in=w_in[l], w_pool=w_pool[l], pool_scale=pool_scale[l],
                   lambda_re=lambda_re[l], lambda_im=lambda_im[l], log_step=log_step[l],
                   b_re=b_re[l], b_im=b_im[l], c_re=c_re[l], c_im=c_im[l], d_skip=d_skip[l],
                   w_glu=w_glu[l], b_glu=b_glu[l], w_out=w_out[l], ln1_g=ln1_g[l], ln1_b=ln1_b[l],
                   w_q=w_q[l], w_o=w_o[l], ln2_g=ln2_g[l], ln2_b=ln2_b[l],
                   w_gate=w_gate[l], w_up=w_up[l], conv_w=conv_w[l], conv_b=conv_b[l],
                   w_down=w_down[l], ln3_g=ln3_g[l], ln3_b=ln3_b[l])
        mk_p, mv_p = mem_kv(mem_prompt, w_k[l], w_v[l])
        zpool = jnp.zeros((nbp, POOL_BUF, D_POOL), x_prompt.dtype)
        zssm = jnp.zeros((nbp, N_SSM_GROUPS, SSM_STATE), state_ssm_re.dtype)
        zconv = jnp.zeros((nbp, CONV_BUF, D_FF), x_prompt.dtype)
        yp, pb, pre, pim, pc = layer(yp, mk_p, mv_p, zpool, 0, zssm, zssm, zconv, **prm)
        ys, sb, sre, sim, sc = layer(ys, cache_mem_k[l], cache_mem_v[l], state_pool[l], PAST_LEN,
                                     state_ssm_re[l], state_ssm_im[l], state_conv[l], **prm)
        p_pool.append(pb); p_re.append(pre); p_im.append(pim); p_conv.append(pc)
        p_mk.append(mk_p); p_mv.append(mv_p)
        s_pool.append(sb); s_re.append(sre); s_im.append(sim); s_conv.append(sc)
    return (yp, ys,
            jnp.stack(p_pool), jnp.stack(p_re), jnp.stack(p_im), jnp.stack(p_conv),
            jnp.stack(p_mk), jnp.stack(p_mv),
            jnp.stack(s_pool), jnp.stack(s_re), jnp.stack(s_im), jnp.stack(s_conv))
```

```cpp
#include <hip/hip_runtime.h>
#include <hip/hip_cooperative_groups.h>
#include <cstdio>
#include <cstdint>
namespace cg = cooperative_groups;

#ifndef MK_PER_PHASE_LAUNCH
#define MK_PER_PHASE_LAUNCH 0
#endif

#define LAS __attribute__((address_space(3)))
typedef unsigned short bf16_t;
typedef short bf16x8 __attribute__((ext_vector_type(8)));
typedef float f32x4 __attribute__((ext_vector_type(4)));
typedef float f32x2 __attribute__((ext_vector_type(2)));
typedef unsigned u32x4 __attribute__((ext_vector_type(4)));
typedef unsigned u32x2 __attribute__((ext_vector_type(2)));

constexpr int DM = 2048, NB = 4, SEQ = 2048, DB = 128, DT = 4;
constexpr int MP = NB * SEQ, MS = DB * DT, MT = MP + MS;
constexpr int DPOOL = 1024, DSSM = 1024, PBUF = 15, NG = 64, NST = 64, CH = 16;
constexpr int NMEM = 256, NH = 4, HD = 512, DFF = 5632;
constexpr float ALPHA = 1.189207115002721f;
constexpr float LN_EPS = 1e-5f;
constexpr float QSCALE = 0.04419417382415922f;

constexpr size_t O_Y = 0;
constexpr size_t O_PPOOL = (size_t)MT * DM;
constexpr size_t O_PRE = O_PPOOL + (size_t)NB * PBUF * DPOOL;
constexpr size_t O_PIM = O_PRE + (size_t)NB * NG * NST;
constexpr size_t O_PCONV = O_PIM + (size_t)NB * NG * NST;
constexpr size_t O_PMK = O_PCONV + (size_t)NB * 2 * DFF;
constexpr size_t O_PMV = O_PMK + (size_t)NB * NMEM * DM;
constexpr size_t O_SPOOL = O_PMV + (size_t)NB * NMEM * DM;
constexpr size_t O_SRE = O_SPOOL + (size_t)DB * PBUF * DPOOL;
constexpr size_t O_SIM = O_SRE + (size_t)DB * NG * NST;
constexpr size_t O_SCONV = O_SIM + (size_t)DB * NG * NST;
constexpr size_t O_END = O_SCONV + (size_t)DB * 2 * DFF;

constexpr size_t MiB = 1u << 20;
constexpr size_t WS_WIN = 1 * MiB;
constexpr size_t WS_WKV = WS_WIN + 8 * MiB;
constexpr size_t WS_WPOOL = WS_WKV + 16 * MiB;
constexpr size_t WS_WGLU = WS_WPOOL + 1 * MiB;
constexpr size_t WS_WOUT = WS_WGLU + 2 * MiB;
constexpr size_t WS_WQ = WS_WOUT + 8 * MiB;
constexpr size_t WS_WO = WS_WQ + 8 * MiB;
constexpr size_t WS_WGU = WS_WO + 8 * MiB;
constexpr size_t WS_WDOWN = WS_WGU + 44 * MiB;
constexpr size_t WS_SSMT = WS_WDOWN + 22 * MiB;
constexpr size_t WS_XB = WS_SSMT + 1 * MiB;
constexpr size_t WS_MEMB = WS_XB + 34 * MiB;
constexpr size_t WS_U = WS_MEMB + 4 * MiB;
constexpr size_t WS_POOLED = WS_U + 68 * MiB;
constexpr size_t WS_Z = WS_POOLED + 17 * MiB;
constexpr size_t WS_MIX = WS_Z + 17 * MiB;
constexpr size_t WS_PRE = WS_MIX + 34 * MiB;
constexpr size_t WS_H1 = WS_PRE + 68 * MiB;
constexpr size_t WS_H2 = WS_H1 + 68 * MiB;
constexpr size_t WS_HB = WS_H2 + 68 * MiB;
constexpr size_t WS_Q = WS_HB + 34 * MiB;
constexpr size_t WS_KB = WS_Q + 34 * MiB;
constexpr size_t WS_VT = WS_KB + 8 * MiB;
constexpr size_t WS_S = WS_VT + 4 * MiB;
constexpr size_t WS_P = WS_S + 32 * MiB;
constexpr size_t WS_AO = WS_P + 16 * MiB;
constexpr size_t WS_GU = WS_AO + 34 * MiB;
constexpr size_t WS_ACT = WS_GU + 187 * MiB;
constexpr size_t WS_END = WS_ACT + 94 * MiB;
constexpr size_t ST_BOP = 0;
constexpr size_t ST_COP = 512 * 1024;
constexpr size_t ST_LAM = 768 * 1024;

constexpr int LDS_BYTES = 147456;

__device__ __forceinline__ unsigned f2bf(float f) { unsigned u = __builtin_bit_cast(unsigned, f); return (u + 0x7fffu + ((u >> 16) & 1u)) >> 16; }
__device__ __forceinline__ unsigned pk2(float lo, float hi) { return f2bf(lo) | (f2bf(hi) << 16); }
__device__ __forceinline__ float bf2f(unsigned h) { return __builtin_bit_cast(float, h << 16); }
__device__ __forceinline__ float wave_sum(float v) {
#pragma unroll
    for (int o = 1; o < 64; o <<= 1) v += __shfl_xor(v, o);
    return v;
}
__device__ __forceinline__ float wave_max(float v) {
#pragma unroll
    for (int o = 1; o < 64; o <<= 1) v = fmaxf(v, __shfl_xor(v, o));
    return v;
}

namespace pg8 {
constexpr int BM = 256, BK = 64, HALF = 128, HTB = HALF * BK * 2, STAGE_BYTES = 8 * HTB, NXCD = 8, WGM = 8;
__device__ __forceinline__ int lds_byte(int r, int c) { const int st = (r >> 4) * 2 + (c >> 5), rr = r & 15, cc = c & 31, ob = rr * 64 + cc * 2; return st * 1024 + (ob ^ (((ob >> 9) & 1) << 5)); }
__device__ __forceinline__ void stage_rc(int b, int& R, int& C) { const int st = b / 1024, sb = b % 1024, swz = sb ^ (((sb >> 9) & 1) << 5); R = (st >> 1) * 16 + swz / 64; C = (st & 1) * 32 + (swz % 64) / 2; }
__device__ __forceinline__ int perm32(int rho) { const int n = rho >> 4, i = rho & 15; return 8 * (i >> 2) + 4 * n + (i & 3); }

struct Unit { const char* a; const char* b; int row0, col0; };
struct Dims { int lda, ldb, K; };

struct GridSched {
    const char* A; const char* B; long a_pm, a_pn, b_pn; int nM, nN, nwg, G, c;
    __device__ __forceinline__ bool next(int i, Unit& u) const {
        const long L = (long)i * G + c; if (L >= nwg) return false;
        int wgid = (int)L; { const int q = nwg / NXCD, r = nwg % NXCD, xcd = wgid % NXCD, off = wgid / NXCD; wgid = (xcd < r ? xcd * (q + 1) : r * (q + 1) + (xcd - r) * q) + off; }
        const int nig = WGM * nN, gid = wgid / nig, fm = gid * WGM, gsz = (nM - fm) < WGM ? (nM - fm) : WGM;
        const int pm = fm + ((wgid % nig) % gsz), pn = (wgid % nig) / gsz;
        u.a = A + pm * a_pm + pn * a_pn; u.b = B + pn * b_pn; u.row0 = pm * BM; u.col0 = pn * BM; return true;
    }
};

template <class Epi, class Sched>
__device__ __forceinline__ void gemm_phase(LAS unsigned char* lds, const Dims g, const Sched& S, const Epi& E) {
    const int tid = threadIdx.x, wid = __builtin_amdgcn_readfirstlane(tid >> 6), lane = tid & 63, wr = wid >> 2, wc = wid & 3, fr = lane & 15, fq = lane >> 4;
    const int K = g.K, nt = K / BK;
    unsigned voffA[2], voffB[2];
#pragma unroll
    for (int i = 0; i < 2; ++i) { int R, C; stage_rc(tid * 16 + i * 8192, R, C); const int Rb = (R & ~31) + perm32(R & 31);
        voffA[i] = (unsigned)(R * g.lda + C) * 2u; voffB[i] = (unsigned)(Rb * g.ldb + C) * 2u; }
    const size_t kstep = (size_t)(BK * 2);
    const size_t hstepA = (size_t)HALF * g.lda * 2, hstepB = (size_t)HALF * g.ldb * 2;
    const unsigned ldsw = (unsigned)wid * 1024u;
    const int aoff = lds_byte(wr * 64 + fr, fq * 8), boff = lds_byte(wc * 32 + fr, fq * 8);
#define PG8_SA(b, h) (((b) * 2 + (h)) * HTB)
#define PG8_SB(b, h) ((4 + (b) * 2 + (h)) * HTB)
#define PG8_STAGE(bufoff, gbase, voff) do { _Pragma("unroll") for (int _i = 0; _i < 2; ++_i) \
        __builtin_amdgcn_global_load_lds((const unsigned*)((const char*)(gbase) + (voff)[_i]), (LAS unsigned*)(lds + (bufoff) + ldsw + _i * 8192), 16, 0, 0); } while (0)
#define PG8_LDA(dst, b, h) do { _Pragma("unroll") for (int m = 0; m < 4; ++m) _Pragma("unroll") for (int k = 0; k < 2; ++k) dst[m][k] = *(const LAS bf16x8*)(lds + PG8_SA(b, h) + aoff + m * 2048 + k * 1024); } while (0)
#define PG8_LDB(dst, b, h) do { _Pragma("unroll") for (int n = 0; n < 2; ++n) _Pragma("unroll") for (int k = 0; k < 2; ++k) dst[n][k] = *(const LAS bf16x8*)(lds + PG8_SB(b, h) + boff + n * 2048 + k * 1024); } while (0)
#define PG8_MMA(ai, bj, At, Bt) do { __builtin_amdgcn_s_setprio(1); _Pragma("unroll") for (int m = 0; m < 4; ++m) _Pragma("unroll") for (int n = 0; n < 2; ++n) _Pragma("unroll") for (int k = 0; k < 2; ++k) \
        acc[ai][bj][m][n] = __builtin_amdgcn_mfma_f32_16x16x32_bf16(Bt[n][k], At[m][k], acc[ai][bj][m][n], 0, 0, 0); __builtin_amdgcn_s_setprio(0); } while (0)
#define PG8_WAIT_V(n) asm volatile("s_waitcnt vmcnt(" #n ")" ::: "memory")
#define PG8_WAIT_L(n) asm volatile("s_waitcnt lgkmcnt(" #n ")" ::: "memory")
#define PG8_BAR __builtin_amdgcn_s_barrier()
#define PG8_SCHED __builtin_amdgcn_sched_barrier(0)
    Unit cur, nxt; int ui = 0;
    if (!S.next(0, cur)) return;
    f32x4 acc[2][2][4][2];
#pragma unroll
    for (int a = 0; a < 2; ++a)
#pragma unroll
        for (int b = 0; b < 2; ++b)
#pragma unroll
            for (int m = 0; m < 4; ++m)
#pragma unroll
                for (int n = 0; n < 2; ++n) acc[a][b][m][n] = (f32x4){0.f, 0.f, 0.f, 0.f};
    bf16x8 At[4][2], B0[2][2], B1[2][2];
    const char* cA = cur.a; const char* cB = cur.b;
    PG8_STAGE(PG8_SB(0, 0), cB, voffB); PG8_STAGE(PG8_SB(0, 1), cB + hstepB, voffB); PG8_STAGE(PG8_SA(0, 0), cA, voffA); PG8_STAGE(PG8_SA(0, 1), cA + hstepA, voffA);
    if (wr == 1) PG8_BAR;
    PG8_WAIT_V(2); PG8_BAR;
    PG8_STAGE(PG8_SB(1, 0), cB + kstep, voffB); PG8_STAGE(PG8_SA(1, 0), cA + kstep, voffA); PG8_STAGE(PG8_SB(1, 1), cB + hstepB + kstep, voffB);
    PG8_WAIT_V(6); PG8_BAR;
    for (;;) {
        const bool has_next = S.next(ui + 1, nxt);
        const char* nA = has_next ? nxt.a : cA; const char* nB = has_next ? nxt.b : cB;
        for (int t = 0; t < nt; t += 2) {
            const bool last = (t == nt - 2);
            const char* a1 = cA + (size_t)(t + 1) * kstep;
            const char* a2 = last ? nA : cA + (size_t)(t + 2) * kstep; const char* b2 = last ? nB : cB + (size_t)(t + 2) * kstep;
            const char* a3 = a2 + kstep; const char* b3 = b2 + kstep;
            PG8_LDB(B0, 0, 0); PG8_LDB(B1, 0, 1); PG8_SCHED; PG8_LDA(At, 0, 0); PG8_STAGE(PG8_SA(1, 1), a1 + hstepA, voffA);
            PG8_WAIT_V(8); PG8_WAIT_L(0); PG8_BAR; PG8_MMA(0, 0, At, B0); PG8_MMA(0, 1, At, B1); PG8_BAR; PG8_SCHED;
            PG8_LDA(At, 0, 1); PG8_STAGE(PG8_SB(0, 0), b2, voffB); PG8_STAGE(PG8_SB(0, 1), b2 + hstepB, voffB); PG8_STAGE(PG8_SA(0, 0), a2, voffA);
            PG8_WAIT_V(8); PG8_WAIT_L(0); PG8_BAR; PG8_MMA(1, 0, At, B0); PG8_MMA(1, 1, At, B1); PG8_BAR; PG8_SCHED;
            PG8_LDB(B0, 1, 0); PG8_LDB(B1, 1, 1); PG8_SCHED; PG8_LDA(At, 1, 0); PG8_STAGE(PG8_SA(0, 1), a2 + hstepA, voffA);
            PG8_WAIT_V(8); PG8_WAIT_L(0); PG8_BAR; PG8_MMA(0, 0, At, B0); PG8_MMA(0, 1, At, B1); PG8_BAR; PG8_SCHED;
            PG8_LDA(At, 1, 1); PG8_STAGE(PG8_SB(1, 0), b3, voffB); PG8_STAGE(PG8_SB(1, 1), b3 + hstepB, voffB); PG8_STAGE(PG8_SA(1, 0), a3, voffA);
            PG8_WAIT_V(8); PG8_WAIT_L(0); PG8_BAR; PG8_MMA(1, 0, At, B0); PG8_MMA(1, 1, At, B1); PG8_BAR; PG8_SCHED;
        }
        if (wr == 0) PG8_BAR;
        E(acc, cur, wr, wc, fr, fq);
        if (!has_next) break;
#pragma unroll
        for (int a = 0; a < 2; ++a)
#pragma unroll
            for (int b = 0; b < 2; ++b)
#pragma unroll
                for (int m = 0; m < 4; ++m)
#pragma unroll
                    for (int n = 0; n < 2; ++n) acc[a][b][m][n] = (f32x4){0.f, 0.f, 0.f, 0.f};
        cur = nxt; cA = nA; cB = nB; ++ui;
        if (wr == 1) PG8_BAR;
    }
    PG8_WAIT_V(0);
    PG8_BAR;
#undef PG8_SA
#undef PG8_SB
#undef PG8_STAGE
#undef PG8_LDA
#undef PG8_LDB
#undef PG8_MMA
#undef PG8_WAIT_V
#undef PG8_WAIT_L
#undef PG8_BAR
#undef PG8_SCHED
}

typedef const f32x4 (&AccRef)[2][2][4][2];

struct EpiStore {
    float* F; bf16_t* Bo; int ld; int split_cols; size_t split_stride; float scale; const float* colscale;
    __device__ __forceinline__ void operator()(AccRef acc, const Unit& u, int wr, int wc, int fr, int fq) const {
        int colt = u.col0; size_t soff = 0;
        if (split_cols) { const int t = colt / split_cols; soff = (size_t)t * split_stride; colt -= t * split_cols; }
        const int col0 = colt + wc * 32 + 8 * fq, row0 = u.row0 + wr * 64 + fr;
        f32x4 cs[2][2];
#pragma unroll
        for (int bj = 0; bj < 2; ++bj)
#pragma unroll
            for (int n = 0; n < 2; ++n) { cs[bj][n] = colscale ? *(const f32x4*)(colscale + col0 + bj * HALF + 4 * n) : (f32x4){1.f, 1.f, 1.f, 1.f}; cs[bj][n] = cs[bj][n] * scale; }
#pragma unroll
        for (int ai = 0; ai < 2; ++ai)
#pragma unroll
            for (int m = 0; m < 4; ++m) {
                const size_t off = soff + (size_t)(row0 + ai * HALF + m * 16) * ld + col0;
#pragma unroll
                for (int bj = 0; bj < 2; ++bj) {
                    const f32x4 v0 = acc[ai][bj][m][0] * cs[bj][0], v1 = acc[ai][bj][m][1] * cs[bj][1];
                    if (F) { *(f32x4*)(F + off + bj * HALF) = v0; *(f32x4*)(F + off + bj * HALF + 4) = v1; }
                    if (Bo) { u32x4 w; w.x = pk2(v0[0], v0[1]); w.y = pk2(v0[2], v0[3]); w.z = pk2(v1[0], v1[1]); w.w = pk2(v1[2], v1[3]); *(u32x4*)(Bo + off + bj * HALF) = w; }
                }
            }
    }
};

struct EpiGlu {
    const bf16_t* Z; const float* bias; bf16_t* O;
    __device__ __forceinline__ void operator()(AccRef acc, const Unit& u, int wr, int wc, int fr, int fq) const {
        const int col0 = u.col0 + wc * 32 + 8 * fq, row0 = u.row0 + wr * 64 + fr;
        f32x4 bv[2][2];
#pragma unroll
        for (int bj = 0; bj < 2; ++bj)
#pragma unroll
            for (int n = 0; n < 2; ++n) bv[bj][n] = *(const f32x4*)(bias + col0 + bj * HALF + 4 * n);
#pragma unroll
        for (int ai = 0; ai < 2; ++ai)
#pragma unroll
            for (int m = 0; m < 4; ++m) {
                const size_t row = (size_t)(row0 + ai * HALF + m * 16);
#pragma unroll
                for (int bj = 0; bj < 2; ++bj) {
                    const u32x4 zz = *(const u32x4*)(Z + row * DSSM + col0 + bj * HALF);
                    const f32x4 a0 = acc[ai][bj][m][0] + bv[bj][0], a1 = acc[ai][bj][m][1] + bv[bj][1];
                    float o[8];
#pragma unroll
                    for (int e = 0; e < 8; ++e) {
                        const unsigned zw = (e < 2) ? zz.x : (e < 4) ? zz.y : (e < 6) ? zz.z : zz.w;
                        const float zf = (e & 1) ? bf2f(zw >> 16) : bf2f(zw & 0xffffu);
                        const float av = (e < 4) ? a0[e & 3] : a1[e & 3];
                        o[e] = zf / (1.f + __expf(-av));
                    }
                    u32x4 w; w.x = pk2(o[0], o[1]); w.y = pk2(o[2], o[3]); w.z = pk2(o[4], o[5]); w.w = pk2(o[6], o[7]);
                    *(u32x4*)(O + row * DM + DPOOL + col0 + bj * HALF) = w;
                }
            }
    }
};

struct EpiResid {
    const float* res0; const float* res1; float* O;
    __device__ __forceinline__ void operator()(AccRef acc, const Unit& u, int wr, int wc, int fr, int fq) const {
        const int col0 = u.col0 + wc * 32 + 8 * fq, row0 = u.row0 + wr * 64 + fr;
        const float* rb = (u.row0 < MP) ? res0 : (res1 - (size_t)MP * DM);
#pragma unroll
        for (int ai = 0; ai < 2; ++ai)
#pragma unroll
            for (int m = 0; m < 4; ++m) {
                const size_t off = (size_t)(row0 + ai * HALF + m * 16) * DM + col0;
#pragma unroll
                for (int bj = 0; bj < 2; ++bj) {
                    const f32x4 r0 = *(const f32x4*)(rb + off + bj * HALF), r1 = *(const f32x4*)(rb + off + bj * HALF + 4);
                    *(f32x4*)(O + off + bj * HALF) = r0 * ALPHA + acc[ai][bj][m][0];
                    *(f32x4*)(O + off + bj * HALF + 4) = r1 * ALPHA + acc[ai][bj][m][1];
                }
                if (m & 1) asm volatile("" ::: "memory");
            }
    }
};

struct EpiGateUp {
    bf16_t* O; float* pconv; float* sconv;
    __device__ __forceinline__ void operator()(AccRef acc, const Unit& u, int wr, int wc, int fr, int fq) const {
        const int col0 = u.col0 + wc * 32 + 8 * fq, row0 = u.row0 + wr * 64 + fr;
        const bool gate = u.col0 < DFF;
#pragma unroll
        for (int ai = 0; ai < 2; ++ai)
#pragma unroll
            for (int m = 0; m < 4; ++m) {
                const int row = row0 + ai * HALF + m * 16;
                const size_t off = (size_t)row * (2 * DFF) + col0;
                float* st = nullptr;
                if (gate) {
                    if (row < MP) { const int t = row & (SEQ - 1); if (t >= SEQ - 2) st = pconv + ((size_t)(row >> 11) * 2 + (t - (SEQ - 2))) * DFF; }
                    else { const int r = row - MP, t = r & 3; if (t >= 2) st = sconv + ((size_t)(r >> 2) * 2 + (t - 2)) * DFF; }
                }
#pragma unroll
                for (int bj = 0; bj < 2; ++bj) {
                    const f32x4 v0 = acc[ai][bj][m][0], v1 = acc[ai][bj][m][1];
                    u32x4 w; w.x = pk2(v0[0], v0[1]); w.y = pk2(v0[2], v0[3]); w.z = pk2(v1[0], v1[1]); w.w = pk2(v1[2], v1[3]);
                    *(u32x4*)(O + off + bj * HALF) = w;
                    if (st) { *(f32x4*)(st + col0 + bj * HALF) = v0; *(f32x4*)(st + col0 + bj * HALF + 4) = v1; }
                }
            }
    }
};

struct SchedS {
    const char* Q; const char* Kb; int G, c;
    __device__ __forceinline__ bool next(int i, Unit& u) const {
        const int L = i * G + c; if (L >= 128) return false;
        const int z = L >> 3, pm = L & 7, b = z >> 2, h = z & 3;
        u.a = Q + ((size_t)(b * SEQ + pm * 256) * DM + h * HD) * 2; u.b = Kb + ((size_t)(b * NMEM) * DM + h * HD) * 2;
        u.row0 = z * SEQ + pm * 256; u.col0 = 0; return true;
    }
};
struct SchedPV {
    const char* P; const char* Vt; int G, c;
    __device__ __forceinline__ bool next(int i, Unit& u) const {
        const int L = i * G + c; if (L >= 256) return false;
        const int pn = L & 1, pm = (L >> 1) & 7, z = L >> 4, b = z >> 2, h = z & 3;
        u.a = P + ((size_t)(z * SEQ + pm * 256) * NMEM) * 2; u.b = Vt + ((size_t)(h * HD + pn * 256) * (NB * NMEM) + b * NMEM) * 2;
        u.row0 = b * SEQ + pm * 256; u.col0 = h * HD + pn * 256; return true;
    }
};
}

struct Args { const float* in[38]; float* out; unsigned char* ws; int ph_lo, ph_hi; };
#define CAS __attribute__((address_space(4)))
typedef const CAS Args* ArgP;
__device__ __forceinline__ int lane_id() { int l = threadIdx.x & 63; asm volatile("" : "+v"(l)); return l; }
__device__ __forceinline__ int wave_id() { int t = threadIdx.x; asm volatile("" : "+v"(t)); return __builtin_amdgcn_readfirstlane(t >> 6); }
__device__ __forceinline__ ArgP argp() { ArgP p = (ArgP)__builtin_amdgcn_kernarg_segment_ptr(); asm volatile("" : "+s"(p)); return p; }

__device__ __forceinline__ void transpose_item(const float* W, int K, int N, bf16_t* WT, int row_off, LAS float* scr, int item, int lane) {
    const int nblk = N / 32, kb = item / nblk, nb = item % nblk, k0 = 64 * kb, n0 = 32 * nb;
#pragma unroll 8
    for (int i = 0; i < 32; ++i) { const int kk = 2 * i + (lane >> 5); scr[kk * 33 + (lane & 31)] = W[(size_t)(k0 + kk) * N + n0 + (lane & 31)]; }
    asm volatile("s_waitcnt lgkmcnt(0)" ::: "memory");
    const int c = lane & 7;
#pragma unroll
    for (int j = 0; j < 4; ++j) { const int n = (lane >> 3) + 8 * j; const LAS float* s = scr + (8 * c) * 33 + n;
        u32x4 o; o.x = pk2(s[0 * 33], s[1 * 33]); o.y = pk2(s[2 * 33], s[3 * 33]); o.z = pk2(s[4 * 33], s[5 * 33]); o.w = pk2(s[6 * 33], s[7 * 33]);
        *(u32x4*)(WT + (size_t)(row_off + n0 + n) * K + k0 + 8 * c) = o; }
    asm volatile("s_waitcnt lgkmcnt(0)" ::: "memory");
}

__device__ __forceinline__ void cvt_rows(const float* src, bf16_t* dst, size_t n8, size_t gtid, size_t nthr) {
    for (size_t i = gtid; i < n8; i += nthr) {
        const f32x4 a = *(const f32x4*)(src + i * 8), b = *(const f32x4*)(src + i * 8 + 4);
        u32x4 w; w.x = pk2(a[0], a[1]); w.y = pk2(a[2], a[3]); w.z = pk2(b[0], b[1]); w.w = pk2(b[2], b[3]);
        *(u32x4*)(dst + i * 8) = w;
    }
}

__device__ __forceinline__ void phase_prep(LAS unsigned char* lds) {
    const int lane = lane_id(), wave = wave_id();
    ArgP A = argp(); unsigned char* ws = A->ws;
    const int G = gridDim.x, gw = blockIdx.x * 8 + wave, NGW = G * 8;
    LAS float* scr = (LAS float*)(lds + wave * 16384);
    constexpr int I_SQ = 2048, I_POOL = 32, I_GLU = 512, I_FF = 5632;
    constexpr int NITEMS = 3 * I_FF + 6 * I_SQ + I_GLU + 4 * I_POOL;
    for (int it = gw; it < NITEMS; it += NGW) {
        int r = it;
        if (r < I_FF) { transpose_item(A->in[31], DM, DFF, (bf16_t*)(ws + WS_WGU), 0, scr, r, lane); continue; } r -= I_FF;
        if (r < I_FF) { transpose_item(A->in[32], DM, DFF, (bf16_t*)(ws + WS_WGU), DFF, scr, r, lane); continue; } r -= I_FF;
        if (r < I_FF) { transpose_item(A->in[35], DFF, DM, (bf16_t*)(ws + WS_WDOWN), 0, scr, r, lane); continue; } r -= I_FF;
        if (r < I_SQ) { transpose_item(A->in[9], DM, DM, (bf16_t*)(ws + WS_WIN), 0, scr, r, lane); continue; } r -= I_SQ;
        if (r < I_SQ) { transpose_item(A->in[26], DM, DM, (bf16_t*)(ws + WS_WKV), 0, scr, r, lane); continue; } r -= I_SQ;
        if (r < I_SQ) { transpose_item(A->in[27], DM, DM, (bf16_t*)(ws + WS_WKV), DM, scr, r, lane); continue; } r -= I_SQ;
        if (r < I_SQ) { transpose_item(A->in[22], DM, DM, (bf16_t*)(ws + WS_WOUT), 0, scr, r, lane); continue; } r -= I_SQ;
        if (r < I_SQ) { transpose_item(A->in[25], DM, DM, (bf16_t*)(ws + WS_WQ), 0, scr, r, lane); continue; } r -= I_SQ;
        if (r < I_SQ) { transpose_item(A->in[28], DM, DM, (bf16_t*)(ws + WS_WO), 0, scr, r, lane); continue; } r -= I_SQ;
        if (r < I_GLU) { transpose_item(A->in[20], DSSM, DSSM, (bf16_t*)(ws + WS_WGLU), 0, scr, r, lane); continue; } r -= I_GLU;
        { const int g = r / I_POOL; transpose_item(A->in[10] + (size_t)g * 65536, 256, 256, (bf16_t*)(ws + WS_WPOOL) + (size_t)g * 65536, 0, scr, r % I_POOL, lane); }
    }
    const size_t gtid = (size_t)blockIdx.x * 512 + threadIdx.x, nthr = (size_t)G * 512;
    cvt_rows(A->in[0], (bf16_t*)(ws + WS_XB), (size_t)MP * DM / 8, gtid, nthr);
    cvt_rows(A->in[1], (bf16_t*)(ws + WS_XB) + (size_t)MP * DM, (size_t)MS * DM / 8, gtid, nthr);
    cvt_rows(A->in[2], (bf16_t*)(ws + WS_MEMB), (size_t)NB * NMEM * DM / 8, gtid, nthr);
    const float* lre = A->in[12]; const float* lim = A->in[13]; const float* lstep = A->in[14];
    const float* bre = A->in[15]; const float* bim = A->in[16]; const float* cre = A->in[17]; const float* cim = A->in[18];
    unsigned char* st = ws + WS_SSMT;
    for (size_t i = gtid; i < (size_t)NG * NST; i += nthr) {
        const int g = (int)(i >> 6), n = (int)(i & 63);
        const float dt = expf(lstep[g]);
        const float ar = lre[i], ai = lim[i];
        const float er = expf(ar * dt); float sn, cs; sincosf(ai * dt, &sn, &cs);
        const float br = er * cs, bi = er * sn;
        ((float*)(st + ST_LAM))[2 * i] = br; ((float*)(st + ST_LAM))[2 * i + 1] = bi;
        const float nr = br - 1.f, ni = bi, den = ar * ar + ai * ai;
        const float fr_ = (nr * ar + ni * ai) / den, fi_ = (ni * ar - nr * ai) / den;
        float pr[16], pi[16];
#pragma unroll
        for (int c = 0; c < 16; ++c) { const float x = bre[i * 16 + c], y = bim[i * 16 + c]; pr[c] = fr_ * x - fi_ * y; pi[c] = fr_ * y + fi_ * x; }
        u32x4* bop = (u32x4*)(st + ST_BOP) + (size_t)g * 8 * 64;
        const int blk = n >> 4, l16 = n & 15;
        u32x4 w;
        w.x = pk2(pr[0], pr[1]); w.y = pk2(pr[2], pr[3]); w.z = pk2(pr[4], pr[5]); w.w = pk2(pr[6], pr[7]); bop[(blk) * 64 + 0 * 16 + l16] = w;
        w.x = pk2(pr[8], pr[9]); w.y = pk2(pr[10], pr[11]); w.z = pk2(pr[12], pr[13]); w.w = pk2(pr[14], pr[15]); bop[(blk) * 64 + 1 * 16 + l16] = w;
        w.x = pk2(pi[0], pi[1]); w.y = pk2(pi[2], pi[3]); w.z = pk2(pi[4], pi[5]); w.w = pk2(pi[6], pi[7]); bop[(4 + blk) * 64 + 0 * 16 + l16] = w;
        w.x = pk2(pi[8], pi[9]); w.y = pk2(pi[10], pi[11]); w.z = pk2(pi[12], pi[13]); w.w = pk2(pi[14], pi[15]); bop[(4 + blk) * 64 + 1 * 16 + l16] = w;
        const u32x4 zz = (u32x4){0u, 0u, 0u, 0u};
        bop[(blk) * 64 + 2 * 16 + l16] = zz; bop[(blk) * 64 + 3 * 16 + l16] = zz; bop[(4 + blk) * 64 + 2 * 16 + l16] = zz; bop[(4 + blk) * 64 + 3 * 16 + l16] = zz;
    }
    for (size_t i = gtid; i < (size_t)NG * 4 * 64; i += nthr) {
        const int L = (int)(i & 63), kk = (int)((i >> 6) & 3), g = (int)(i >> 8);
        const int c = L & 15, q = L >> 4, k0 = 32 * kk + 8 * q;
        float v[8];
#pragma unroll
        for (int e = 0; e < 8; ++e) { const int k = k0 + e; v[e] = (k < 64) ? cre[((size_t)g * 16 + c) * 64 + k] : -cim[((size_t)g * 16 + c) * 64 + (k - 64)]; }
        u32x4 w; w.x = pk2(v[0], v[1]); w.y = pk2(v[2], v[3]); w.z = pk2(v[4], v[5]); w.w = pk2(v[6], v[7]);
        ((u32x4*)(st + ST_COP))[i] = w;
    }
}

__device__ __forceinline__ void phase_pool() {
    ArgP A = argp(); unsigned char* ws = A->ws; const float* U = (const float*)(ws + WS_U); bf16_t* PO = (bf16_t*)(ws + WS_POOLED);
    const size_t gtid = (size_t)blockIdx.x * 512 + threadIdx.x, nthr = (size_t)gridDim.x * 512;
    for (size_t it = gtid; it < (size_t)(MP / 16) * 256; it += nthr) {
        const int qd = (int)(it & 255), tb = (int)(it >> 8), ch = qd * 4, w = 2 << (ch >> 8);
        const int row0 = tb * 16, t0 = row0 & (SEQ - 1);
        const float* up = U + (size_t)row0 * DM + ch;
        f32x4 s = (f32x4){0.f, 0.f, 0.f, 0.f};
        for (int j = 1; j < w; ++j) if (t0 - j >= 0) s += *(const f32x4*)(up - (size_t)j * DM);
        for (int j = 0; j < 16; ++j) {
            const f32x4 x = *(const f32x4*)(up + (size_t)j * DM);
            s += x;
            const int t = t0 + j; const float inv = 1.f / (float)((t + 1 < w) ? (t + 1) : w);
            const f32x4 o = s * inv - x;
            u32x2 pk; pk.x = pk2(o[0], o[1]); pk.y = pk2(o[2], o[3]);
            *(u32x2*)(PO + (size_t)(row0 + j) * DPOOL + ch) = pk;
            if (t - w + 1 >= 0) s -= *(const f32x4*)(up + (size_t)(j - w + 1) * DM);
        }
    }
    const float* SP = A->in[3];
    for (size_t it = gtid; it < (size_t)DB * 256; it += nthr) {
        const int qd = (int)(it & 255), b = (int)(it >> 8), ch = qd * 4, w = 2 << (ch >> 8);
        const float* sp = SP + (size_t)b * PBUF * DPOOL + ch;
        const float* up = U + (size_t)(MP + b * 4) * DM + ch;
        f32x4 s = (f32x4){0.f, 0.f, 0.f, 0.f};
        for (int j = 1; j < w; ++j) s += *(const f32x4*)(sp + (size_t)(PBUF - j) * DPOOL);
        const float inv = 1.f / (float)w;
        for (int j = 0; j < 4; ++j) {
            const f32x4 x = *(const f32x4*)(up + (size_t)j * DM);
            s += x;
            const f32x4 o = s * inv - x;
            u32x2 pk; pk.x = pk2(o[0], o[1]); pk.y = pk2(o[2], o[3]);
            *(u32x2*)(PO + (size_t)(MP + b * 4 + j) * DPOOL + ch) = pk;
            const int e = 15 + j - w + 1;
            s -= (e < PBUF) ? *(const f32x4*)(sp + (size_t)e * DPOOL) : *(const f32x4*)(up + (size_t)(e - PBUF) * DM);
        }
    }
    float* out = A->out;
    for (size_t it = gtid; it < (size_t)NB * PBUF * 256; it += nthr) {
        const int qd = (int)(it & 255), r = (int)(it >> 8), b = r / PBUF, j = r % PBUF;
        *(f32x4*)(out + O_PPOOL + (size_t)r * DPOOL + qd * 4) = *(const f32x4*)(U + (size_t)(b * SEQ + SEQ - PBUF + j) * DM + qd * 4);
    }
    for (size_t it = gtid; it < (size_t)DB * PBUF * 256; it += nthr) {
        const int qd = (int)(it & 255), r = (int)(it >> 8), b = r / PBUF, j = r % PBUF;
        const f32x4 v = (j < PBUF - DT) ? *(const f32x4*)(SP + ((size_t)b * PBUF + j + DT) * DPOOL + qd * 4) : *(const f32x4*)(U + (size_t)(MP + b * 4 + (j - (PBUF - DT))) * DM + qd * 4);
        *(f32x4*)(out + O_SPOOL + (size_t)r * DPOOL + qd * 4) = v;
    }
}

constexpr int BU_LD = 132;
constexpr int HB_LD = 136;
constexpr int SSM_WAVE_LDS = 16 * BU_LD * 4 + 16 * HB_LD * 2;

__device__ __forceinline__ float gelu_tanh(float y) { const float t = 1.5957691216f * (y + 0.044715f * y * y * y); return y / (1.f + __expf(-t)); }

__device__ __forceinline__ void ssm_bu_tile(const float* U, int row0, int g, int lane, const bf16x8 (&Bop)[8], LAS float* bu) {
    const int l16 = lane & 15, q = lane >> 4;
    bf16x8 ub = (bf16x8){0, 0, 0, 0, 0, 0, 0, 0};
    if (q < 2) {
        const float* p = U + (size_t)(row0 + l16) * DM + DPOOL + g * CH + 8 * q;
        const f32x4 a = *(const f32x4*)p, b = *(const f32x4*)(p + 4);
        u32x4 w; w.x = pk2(a[0], a[1]); w.y = pk2(a[2], a[3]); w.z = pk2(b[0], b[1]); w.w = pk2(b[2], b[3]);
        ub = __builtin_bit_cast(bf16x8, w);
    }
#pragma unroll
    for (int blk = 0; blk < 8; ++blk) {
        const f32x4 d = __builtin_amdgcn_mfma_f32_16x16x32_bf16(Bop[blk], ub, (f32x4){0.f, 0.f, 0.f, 0.f}, 0, 0, 0);
        *(LAS f32x4*)(bu + l16 * BU_LD + 16 * blk + 4 * q) = d;
    }
}
__device__ __forceinline__ void ssm_y_tile(const float* U, const float* dskip, bf16_t* Z, int row0, int g, int lane, const bf16x8 (&Cop)[4], const LAS bf16_t* hb) {
    const int l16 = lane & 15, q = lane >> 4;
    f32x4 acc = (f32x4){0.f, 0.f, 0.f, 0.f};
#pragma unroll
    for (int kk = 0; kk < 4; ++kk) {
        const bf16x8 b = *(const LAS bf16x8*)(hb + l16 * HB_LD + 32 * kk + 8 * q);
        acc = __builtin_amdgcn_mfma_f32_16x16x32_bf16(Cop[kk], b, acc, 0, 0, 0);
    }
    const int row = row0 + l16, ch = g * CH + 4 * q;
    const f32x4 uu = *(const f32x4*)(U + (size_t)row * DM + DPOOL + ch), dk = *(const f32x4*)(dskip + ch);
    const f32x4 y = acc + dk * uu;
    u32x2 pk; pk.x = pk2(gelu_tanh(y[0]), gelu_tanh(y[1])); pk.y = pk2(gelu_tanh(y[2]), gelu_tanh(y[3]));
    *(u32x2*)(Z + (size_t)row * DSSM + ch) = pk;
}

__device__ __forceinline__ void phase_ssm(LAS unsigned char* lds) {
    const int lane = lane_id(), wave = wave_id();
    ArgP A = argp(); unsigned char* ws = A->ws; const float* U = (const float*)(ws + WS_U); bf16_t* Z = (bf16_t*)(ws + WS_Z);
    const unsigned char* st = ws + WS_SSMT; const float* dskip = A->in[19]; float* out = A->out;
    LAS float* bu = (LAS float*)(lds + wave * SSM_WAVE_LDS);
    LAS bf16_t* hb = (LAS bf16_t*)(lds + wave * SSM_WAVE_LDS + 16 * BU_LD * 4);
    LAS float* xs = (LAS float*)(lds + 8 * SSM_WAVE_LDS);
    for (int task = blockIdx.x; task < NB * NG; task += gridDim.x) {
        const int b = task >> 6, g = task & 63;
        bf16x8 Bop[8], Cop[4];
#pragma unroll
        for (int i = 0; i < 8; ++i) Bop[i] = *(const bf16x8*)(st + ST_BOP + ((size_t)(g * 8 + i) * 64 + lane) * 16);
#pragma unroll
        for (int i = 0; i < 4; ++i) Cop[i] = *(const bf16x8*)(st + ST_COP + ((size_t)(g * 4 + i) * 64 + lane) * 16);
        const float lr = ((const float*)(st + ST_LAM))[2 * (g * 64 + lane)], li = ((const float*)(st + ST_LAM))[2 * (g * 64 + lane) + 1];
        const int rowb = b * SEQ + wave * 256;
        float hr = 0.f, hi = 0.f;
        for (int tl = 0; tl < 16; ++tl) {
            ssm_bu_tile(U, rowb + tl * 16, g, lane, Bop, bu);
#pragma unroll
            for (int j = 0; j < 16; ++j) { const float br = bu[j * BU_LD + lane], bi = bu[j * BU_LD + 64 + lane];
                const float nr = lr * hr - li * hi + br, ni = lr * hi + li * hr + bi; hr = nr; hi = ni; }
        }
        xs[(wave * 64 + lane) * 2] = hr; xs[(wave * 64 + lane) * 2 + 1] = hi;
        __syncthreads();
        float pr = lr, pi = li;
#pragma unroll
        for (int s = 0; s < 8; ++s) { const float a = pr * pr - pi * pi, c = 2.f * pr * pi; pr = a; pi = c; }
        hr = 0.f; hi = 0.f;
        for (int w2 = 0; w2 < wave; ++w2) { const float sr = xs[(w2 * 64 + lane) * 2], si = xs[(w2 * 64 + lane) * 2 + 1];
            const float nr = pr * hr - pi * hi + sr, ni = pr * hi + pi * hr + si; hr = nr; hi = ni; }
        for (int tl = 0; tl < 16; ++tl) {
            ssm_bu_tile(U, rowb + tl * 16, g, lane, Bop, bu);
#pragma unroll
            for (int j = 0; j < 16; ++j) { const float br = bu[j * BU_LD + lane], bi = bu[j * BU_LD + 64 + lane];
                const float nr = lr * hr - li * hi + br, ni = lr * hi + li * hr + bi; hr = nr; hi = ni;
                hb[j * HB_LD + lane] = (bf16_t)f2bf(hr); hb[j * HB_LD + 64 + lane] = (bf16_t)f2bf(hi); }
            ssm_y_tile(U, dskip, Z, rowb + tl * 16, g, lane, Cop, hb);
        }
        if (wave == 7) { out[O_PRE + (size_t)(b * NG + g) * NST + lane] = hr; out[O_PIM + (size_t)(b * NG + g) * NST + lane] = hi; }
        __syncthreads();
    }
    const float* s0r = A->in[4]; const float* s0i = A->in[5];
    for (int task = blockIdx.x * 8 + wave; task < NG * (DB / 4); task += gridDim.x * 8) {
        const int g = task & 63, bq = task >> 6;
        bf16x8 Bop[8], Cop[4];
#pragma unroll
        for (int i = 0; i < 8; ++i) Bop[i] = *(const bf16x8*)(st + ST_BOP + ((size_t)(g * 8 + i) * 64 + lane) * 16);
#pragma unroll
        for (int i = 0; i < 4; ++i) Cop[i] = *(const bf16x8*)(st + ST_COP + ((size_t)(g * 4 + i) * 64 + lane) * 16);
        const float lr = ((const float*)(st + ST_LAM))[2 * (g * 64 + lane)], li = ((const float*)(st + ST_LAM))[2 * (g * 64 + lane) + 1];
        const int row0 = MP + bq * 16;
        ssm_bu_tile(U, row0, g, lane, Bop, bu);
        float hr = 0.f, hi = 0.f;
#pragma unroll
        for (int j = 0; j < 16; ++j) {
            const int bb = bq * 4 + (j >> 2);
            if ((j & 3) == 0) { hr = s0r[(size_t)(bb * NG + g) * NST + lane]; hi = s0i[(size_t)(bb * NG + g) * NST + lane]; }
            const float br = bu[j * BU_LD + lane], bi = bu[j * BU_LD + 64 + lane];
            const float nr = lr * hr - li * hi + br, ni = lr * hi + li * hr + bi; hr = nr; hi = ni;
            hb[j * HB_LD + lane] = (bf16_t)f2bf(hr); hb[j * HB_LD + 64 + lane] = (bf16_t)f2bf(hi);
            if ((j & 3) == 3) { out[O_SRE + (size_t)(bb * NG + g) * NST + lane] = hr; out[O_SIM + (size_t)(bb * NG + g) * NST + lane] = hi; }
        }
        ssm_y_tile(U, dskip, Z, row0, g, lane, Cop, hb);
    }
}

template <bool FINAL>
__device__ __forceinline__ void phase_ln(const float* X, const float* gam, const float* bet, float* O32, bf16_t* O16) {
    const int lane = lane_id(), wave = wave_id();
    const int gw = blockIdx.x * 8 + wave, NGW = gridDim.x * 8;
    for (int row = gw; row < MT; row += NGW) {
        const f32x4* xr = (const f32x4*)(X + (size_t)row * DM) + lane;
        f32x4 v[8]; float s = 0.f;
#pragma unroll
        for (int j = 0; j < 8; ++j) { v[j] = xr[64 * j]; s += (v[j][0] + v[j][1]) + (v[j][2] + v[j][3]); }
        const float mean = wave_sum(s) * (1.f / DM); float s2 = 0.f;
#pragma unroll
        for (int j = 0; j < 8; ++j) { v[j] = v[j] - mean; s2 += (v[j][0] * v[j][0] + v[j][1] * v[j][1]) + (v[j][2] * v[j][2] + v[j][3] * v[j][3]); }
        const float rstd = 1.f / sqrtf(wave_sum(s2) * (1.f / DM) + LN_EPS);
#pragma unroll
        for (int j = 0; j < 8; ++j) {
            const f32x4 gg = ((const f32x4*)gam)[lane + 64 * j], bb = ((const f32x4*)bet)[lane + 64 * j];
            const f32x4 o = v[j] * rstd * gg + bb;
            ((f32x4*)(O32 + (size_t)row * DM))[lane + 64 * j] = o;
            if (!FINAL) { u32x2 pk; pk.x = pk2(o[0], o[1]); pk.y = pk2(o[2], o[3]); ((u32x2*)(O16 + (size_t)row * DM))[lane + 64 * j] = pk; }
        }
    }
}

__device__ __forceinline__ void phase_softmax(const float* S, bf16_t* P) {
    const int lane = lane_id(), wave = wave_id();
    const int gw = blockIdx.x * 8 + wave, NGW = gridDim.x * 8;
    for (int row = gw; row < NB * NH * SEQ; row += NGW) {
        const f32x4 v = ((const f32x4*)(S + (size_t)row * NMEM))[lane];
        const float mx = wave_max(fmaxf(fmaxf(v[0], v[1]), fmaxf(v[2], v[3])));
        const float e0 = __expf(v[0] - mx), e1 = __expf(v[1] - mx), e2 = __expf(v[2] - mx), e3 = __expf(v[3] - mx);
        const float inv = 1.f / wave_sum((e0 + e1) + (e2 + e3));
        u32x2 pk; pk.x = pk2(e0 * inv, e1 * inv); pk.y = pk2(e2 * inv, e3 * inv);
        ((u32x2*)(P + (size_t)row * NMEM))[lane] = pk;
    }
}

__device__ __forceinline__ void phase_attn_sample(LAS unsigned char* lds) {
    const int lane = lane_id(), wave = wave_id();
    ArgP A = argp();
    const bf16_t* Q = (const bf16_t*)(A->ws + WS_Q); bf16_t* AO = (bf16_t*)(A->ws + WS_AO);
    const float* CK = A->in[7]; const float* CV = A->in[8];
    LAS float* sS = (LAS float*)lds;
    LAS float* sP = (LAS float*)(lds + 4096);
    LAS float* sR = (LAS float*)(lds + 8192);
    const int l16 = lane & 15, q = lane >> 4;
    for (int task = blockIdx.x; task < DB * NH; task += gridDim.x) {
        const int b = task >> 2, h = task & 3;
        f32x4 sacc[2] = {(f32x4){0.f, 0.f, 0.f, 0.f}, (f32x4){0.f, 0.f, 0.f, 0.f}};
        const bf16_t* qrow = Q + (size_t)(MP + b * 4 + (l16 & 3)) * DM + h * HD + 4 * q;
        const float* k0p = CK + ((size_t)(b * NMEM + wave * 32 + l16) * NH + h) * HD + 4 * q;
        const float* k1p = k0p + (size_t)16 * NH * HD;
#pragma unroll 4
        for (int ks = 0; ks < 16; ++ks) {
            u32x2 qa = *(const u32x2*)(qrow + 32 * ks), qb = *(const u32x2*)(qrow + 32 * ks + 16);
            if (l16 >= 4) { qa = (u32x2){0u, 0u}; qb = (u32x2){0u, 0u}; }
            const u32x4 aw = (u32x4){qa.x, qa.y, qb.x, qb.y};
            const f32x4 x0 = __builtin_nontemporal_load((const f32x4*)(k0p + 32 * ks)), x1 = __builtin_nontemporal_load((const f32x4*)(k0p + 32 * ks + 16));
            const f32x4 y0 = __builtin_nontemporal_load((const f32x4*)(k1p + 32 * ks)), y1 = __builtin_nontemporal_load((const f32x4*)(k1p + 32 * ks + 16));
            u32x4 bw0, bw1;
            bw0.x = pk2(x0[0], x0[1]); bw0.y = pk2(x0[2], x0[3]); bw0.z = pk2(x1[0], x1[1]); bw0.w = pk2(x1[2], x1[3]);
            bw1.x = pk2(y0[0], y0[1]); bw1.y = pk2(y0[2], y0[3]); bw1.z = pk2(y1[0], y1[1]); bw1.w = pk2(y1[2], y1[3]);
            sacc[0] = __builtin_amdgcn_mfma_f32_16x16x32_bf16(__builtin_bit_cast(bf16x8, aw), __builtin_bit_cast(bf16x8, bw0), sacc[0], 0, 0, 0);
            sacc[1] = __builtin_amdgcn_mfma_f32_16x16x32_bf16(__builtin_bit_cast(bf16x8, aw), __builtin_bit_cast(bf16x8, bw1), sacc[1], 0, 0, 0);
        }
        if (q == 0) {
#pragma unroll
            for (int t = 0; t < 4; ++t) { sS[t * 256 + wave * 32 + l16] = sacc[0][t]; sS[t * 256 + wave * 32 + 16 + l16] = sacc[1][t]; }
        }
        __syncthreads();
        if (wave < 4) {
            const f32x4 v = *(LAS f32x4*)(sS + wave * 256 + 4 * lane);
            const float mx = wave_max(fmaxf(fmaxf(v[0], v[1]), fmaxf(v[2], v[3])));
            const float e0 = __expf(v[0] - mx), e1 = __expf(v[1] - mx), e2 = __expf(v[2] - mx), e3 = __expf(v[3] - mx);
            const float inv = 1.f / wave_sum((e0 + e1) + (e2 + e3));
            sP[(4 * lane + 0) * 4 + wave] = e0 * inv; sP[(4 * lane + 1) * 4 + wave] = e1 * inv; sP[(4 * lane + 2) * 4 + wave] = e2 * inv; sP[(4 * lane + 3) * 4 + wave] = e3 * inv;
        }
        __syncthreads();
        f32x4 o0[4], o1[4];
#pragma unroll
        for (int t = 0; t < 4; ++t) { o0[t] = (f32x4){0.f, 0.f, 0.f, 0.f}; o1[t] = (f32x4){0.f, 0.f, 0.f, 0.f}; }
        const float* vp = CV + ((size_t)(b * NMEM + wave * 32) * NH + h) * HD + 4 * lane;
#pragma unroll 8
        for (int kx = 0; kx < 32; ++kx) {
            const f32x4 v0 = __builtin_nontemporal_load((const f32x4*)(vp + (size_t)kx * NH * HD)), v1 = __builtin_nontemporal_load((const f32x4*)(vp + (size_t)kx * NH * HD + 256));
            const f32x4 p = *(LAS f32x4*)(sP + (wave * 32 + kx) * 4);
#pragma unroll
            for (int t = 0; t < 4; ++t) { o0[t] += v0 * p[t]; o1[t] += v1 * p[t]; }
        }
#pragma unroll
        for (int t = 0; t < 4; ++t) { *(LAS f32x4*)(sR + (wave * 4 + t) * 512 + 4 * lane) = o0[t]; *(LAS f32x4*)(sR + (wave * 4 + t) * 512 + 256 + 4 * lane) = o1[t]; }
        __syncthreads();
        {
            const int t = threadIdx.x >> 7, d4 = (threadIdx.x & 127) * 4;
            f32x4 s = (f32x4){0.f, 0.f, 0.f, 0.f};
#pragma unroll
            for (int w2 = 0; w2 < 8; ++w2) s += *(LAS f32x4*)(sR + (w2 * 4 + t) * 512 + d4);
            u32x2 pk; pk.x = pk2(s[0], s[1]); pk.y = pk2(s[2], s[3]);
            *(u32x2*)(AO + (size_t)(MP + b * 4 + t) * DM + h * HD + d4) = pk;
        }
        __syncthreads();
    }
}

__device__ __forceinline__ void phase_act() {
    ArgP A = argp();
    const bf16_t* GU = (const bf16_t*)(A->ws + WS_GU); bf16_t* ACT = (bf16_t*)(A->ws + WS_ACT);
    const float* cw = A->in[33]; const float* cb = A->in[34]; const float* sc = A->in[6];
    const size_t gtid = (size_t)blockIdx.x * 512 + threadIdx.x, nthr = (size_t)gridDim.x * 512;
    constexpr int FG = DFF / 8;
    for (size_t it = gtid; it < (size_t)MT * FG; it += nthr) {
        const int fg = (int)(it % FG), row = (int)(it / FG), f0 = fg * 8;
        float g0[8], g1[8], g2[8], up[8];
        { const u32x4 w = *(const u32x4*)(GU + (size_t)row * (2 * DFF) + f0);
          g2[0] = bf2f(w.x & 0xffffu); g2[1] = bf2f(w.x >> 16); g2[2] = bf2f(w.y & 0xffffu); g2[3] = bf2f(w.y >> 16); g2[4] = bf2f(w.z & 0xffffu); g2[5] = bf2f(w.z >> 16); g2[6] = bf2f(w.w & 0xffffu); g2[7] = bf2f(w.w >> 16); }
        { const u32x4 w = *(const u32x4*)(GU + (size_t)row * (2 * DFF) + DFF + f0);
          up[0] = bf2f(w.x & 0xffffu); up[1] = bf2f(w.x >> 16); up[2] = bf2f(w.y & 0xffffu); up[3] = bf2f(w.y >> 16); up[4] = bf2f(w.z & 0xffffu); up[5] = bf2f(w.z >> 16); up[6] = bf2f(w.w & 0xffffu); up[7] = bf2f(w.w >> 16); }
        int t; const float* sb = nullptr;
        if (row < MP) t = row & (SEQ - 1); else { const int r = row - MP; t = r & 3; sb = sc + (size_t)(r >> 2) * 2 * DFF + f0; }
#pragma unroll
        for (int d = 1; d <= 2; ++d) {
            float* gd = (d == 1) ? g1 : g0;
            if (t - d >= 0) { const u32x4 w = *(const u32x4*)(GU + (size_t)(row - d) * (2 * DFF) + f0);
                gd[0] = bf2f(w.x & 0xffffu); gd[1] = bf2f(w.x >> 16); gd[2] = bf2f(w.y & 0xffffu); gd[3] = bf2f(w.y >> 16); gd[4] = bf2f(w.z & 0xffffu); gd[5] = bf2f(w.z >> 16); gd[6] = bf2f(w.w & 0xffffu); gd[7] = bf2f(w.w >> 16); }
            else if (sb) { const float* p = sb + (size_t)(2 + t - d) * DFF; const f32x4 a = *(const f32x4*)p, b = *(const f32x4*)(p + 4);
                gd[0] = a[0]; gd[1] = a[1]; gd[2] = a[2]; gd[3] = a[3]; gd[4] = b[0]; gd[5] = b[1]; gd[6] = b[2]; gd[7] = b[3]; }
            else {
#pragma unroll
                for (int e = 0; e < 8; ++e) gd[e] = 0.f; }
        }
        float o[8];
#pragma unroll
        for (int e = 0; e < 8; ++e) {
            const float gc = cb[f0 + e] + g0[e] * cw[f0 + e] + g1[e] * cw[DFF + f0 + e] + g2[e] * cw[2 * DFF + f0 + e];
            o[e] = gc / (1.f + __expf(-gc)) * up[e];
        }
        u32x4 w; w.x = pk2(o[0], o[1]); w.y = pk2(o[2], o[3]); w.z = pk2(o[4], o[5]); w.w = pk2(o[6], o[7]);
        *(u32x4*)(ACT + (size_t)row * DFF + f0) = w;
    }
}

constexpr int N_PHASES = 16;
__global__ void __launch_bounds__(512, 2) fwd_megakernel(Args args) {
    extern __shared__ __attribute__((aligned(16))) unsigned char lds_raw[];
    LAS unsigned char* lds = (LAS unsigned char*)lds_raw;
    const int G = gridDim.x, c0 = blockIdx.x;
    unsigned char* const ws = argp()->ws;
    const int lo = argp()->ph_lo, hi = argp()->ph_hi;
#define out (argp()->out)
    cg::grid_group grid = cg::this_grid();
#define IN(k) (lo <= (k) && (k) < hi)
#define SEAM(k) do { if (IN(k) && IN((k) + 1)) grid.sync(); } while (0)
    using namespace pg8;
    const bf16_t* XB = (const bf16_t*)(ws + WS_XB);

    if (IN(0)) { phase_prep(lds); }
    SEAM(0);
    if (IN(1)) {
        {
            GridSched S{(const char*)XB, (const char*)(ws + WS_WIN), (long)256 * DM * 2, 0, (long)256 * DM * 2, MT / 256, DM / 256, (MT / 256) * (DM / 256), G, c0};
            EpiStore E{(float*)(ws + WS_U), nullptr, DM, 0, 0, 1.f, nullptr};
            gemm_phase(lds, Dims{DM, DM, DM}, S, E);
        }
        {
            GridSched S{(const char*)(ws + WS_MEMB), (const char*)(ws + WS_WKV), (long)256 * DM * 2, 0, (long)256 * DM * 2, 4, 16, 64, G, (c0 + G - 16) % G};
            EpiStore E{out + O_PMK, (bf16_t*)(ws + WS_KB), DM, DM, (size_t)NB * NMEM * DM, 1.f, nullptr};
            gemm_phase(lds, Dims{DM, DM, DM}, S, E);
        }
        {
            GridSched S{(const char*)(ws + WS_WKV) + (size_t)DM * DM * 2, (const char*)(ws + WS_MEMB), (long)256 * DM * 2, 0, (long)256 * DM * 2, 8, 4, 32, G, (c0 + G - 80) % G};
            EpiStore E{nullptr, (bf16_t*)(ws + WS_VT), NB * NMEM, 0, 0, 1.f, nullptr};
            gemm_phase(lds, Dims{DM, DM, DM}, S, E);
        }
    }
    SEAM(1);
    if (IN(2)) { phase_pool(); phase_ssm(lds); }
    SEAM(2);
    if (IN(3)) {
        {
            GridSched S{(const char*)(ws + WS_POOLED), (const char*)(ws + WS_WPOOL), (long)256 * DPOOL * 2, (long)256 * 2, (long)256 * 256 * 2, MT / 256, 4, (MT / 256) * 4, G, c0};
            EpiStore E{nullptr, (bf16_t*)(ws + WS_MIX), DM, 0, 0, 1.f, argp()->in[11]};
            gemm_phase(lds, Dims{DPOOL, 256, 256}, S, E);
        }
        {
            GridSched S{(const char*)(ws + WS_Z), (const char*)(ws + WS_WGLU), (long)256 * DSSM * 2, 0, (long)256 * DSSM * 2, MT / 256, 4, (MT / 256) * 4, G, (c0 + G - 136) % G};
            EpiGlu E{(const bf16_t*)(ws + WS_Z), argp()->in[21], (bf16_t*)(ws + WS_MIX)};
            gemm_phase(lds, Dims{DSSM, DSSM, DSSM}, S, E);
        }
    }
    SEAM(3);
    if (IN(4)) {
        GridSched S{(const char*)(ws + WS_MIX), (const char*)(ws + WS_WOUT), (long)256 * DM * 2, 0, (long)256 * DM * 2, MT / 256, DM / 256, (MT / 256) * (DM / 256), G, c0};
        EpiResid E{argp()->in[0], argp()->in[1], (float*)(ws + WS_PRE)};
        gemm_phase(lds, Dims{DM, DM, DM}, S, E);
    }
    SEAM(4);
    if (IN(5)) { phase_ln<false>((const float*)(ws + WS_PRE), argp()->in[23], argp()->in[24], (float*)(ws + WS_H1), (bf16_t*)(ws + WS_HB)); }
    SEAM(5);
    if (IN(6)) {
        GridSched S{(const char*)(ws + WS_HB), (const char*)(ws + WS_WQ), (long)256 * DM * 2, 0, (long)256 * DM * 2, MT / 256, DM / 256, (MT / 256) * (DM / 256), G, c0};
        EpiStore E{nullptr, (bf16_t*)(ws + WS_Q), DM, 0, 0, QSCALE, nullptr};
        gemm_phase(lds, Dims{DM, DM, DM}, S, E);
    }
    SEAM(6);
    if (IN(7)) {
        {
            SchedS S{(const char*)(ws + WS_Q), (const char*)(ws + WS_KB), G, c0};
            EpiStore E{(float*)(ws + WS_S), nullptr, NMEM, 0, 0, 1.f, nullptr};
            gemm_phase(lds, Dims{DM, DM, HD}, S, E);
        }
        phase_attn_sample(lds);
    }
    SEAM(7);
    if (IN(8)) { phase_softmax((const float*)(ws + WS_S), (bf16_t*)(ws + WS_P)); }
    SEAM(8);
    if (IN(9)) {
        SchedPV S{(const char*)(ws + WS_P), (const char*)(ws + WS_VT), G, c0};
        EpiStore E{nullptr, (bf16_t*)(ws + WS_AO), DM, 0, 0, 1.f, nullptr};
        gemm_phase(lds, Dims{NMEM, NB * NMEM, NMEM}, S, E);
    }
    SEAM(9);
    if (IN(10)) {
        GridSched S{(const char*)(ws + WS_AO), (const char*)(ws + WS_WO), (long)256 * DM * 2, 0, (long)256 * DM * 2, MT / 256, DM / 256, (MT / 256) * (DM / 256), G, c0};
        EpiResid E{(const float*)(ws + WS_H1), (const float*)(ws + WS_H1) + (size_t)MP * DM, (float*)(ws + WS_PRE)};
        gemm_phase(lds, Dims{DM, DM, DM}, S, E);
    }
    SEAM(10);
    if (IN(11)) { phase_ln<false>((const float*)(ws + WS_PRE), argp()->in[29], argp()->in[30], (float*)(ws + WS_H2), (bf16_t*)(ws + WS_HB)); }
    SEAM(11);
    if (IN(12)) {
        GridSched S{(const char*)(ws + WS_HB), (const char*)(ws + WS_WGU), (long)256 * DM * 2, 0, (long)256 * DM * 2, MT / 256, 2 * DFF / 256, (MT / 256) * (2 * DFF / 256), G, c0};
        EpiGateUp E{(bf16_t*)(ws + WS_GU), out + O_PCONV, out + O_SCONV};
        gemm_phase(lds, Dims{DM, DM, DM}, S, E);
    }
    SEAM(12);
    if (IN(13)) { phase_act(); }
    SEAM(13);
    if (IN(14)) {
        GridSched S{(const char*)(ws + WS_ACT), (const char*)(ws + WS_WDOWN), (long)256 * DFF * 2, 0, (long)256 * DFF * 2, MT / 256, DM / 256, (MT / 256) * (DM / 256), G, c0};
        EpiResid E{(const float*)(ws + WS_H2), (const float*)(ws + WS_H2) + (size_t)MP * DM, (float*)(ws + WS_PRE)};
        gemm_phase(lds, Dims{DFF, DFF, DFF}, S, E);
    }
    SEAM(14);
    if (IN(15)) { phase_ln<true>((const float*)(ws + WS_PRE), argp()->in[36], argp()->in[37], out + O_Y, nullptr); }
#undef IN
#undef SEAM
#undef out
}

extern "C" void kernel_launch(void* const* d_in, const int* in_sizes, int n_in, void* d_out, int out_size, void* d_ws, size_t ws_size, hipStream_t stream) {
    static int grid = 0;
    if (grid == 0) {
        if (n_in != 38 || (size_t)out_size != O_END || ws_size < WS_END) { fprintf(stderr, "kernel_launch: unexpected shapes: n_in %d out %d (want %zu) ws %zu (want %zu)\n", n_in, out_size, (size_t)O_END, ws_size, (size_t)WS_END); grid = -1; return; }
        int dev = 0, cus = 0, per_cu = 0;
        hipGetDevice(&dev);
        hipDeviceGetAttribute(&cus, hipDeviceAttributeMultiprocessorCount, dev);
        if (hipFuncSetAttribute((const void*)fwd_megakernel, hipFuncAttributeMaxDynamicSharedMemorySize, LDS_BYTES) != hipSuccess) { fprintf(stderr, "kernel_launch: hipFuncSetAttribute failed\n"); grid = -1; return; }
        if (hipOccupancyMaxActiveBlocksPerMultiprocessor(&per_cu, (const void*)fwd_megakernel, 512, LDS_BYTES) != hipSuccess || per_cu < 1) { fprintf(stderr, "kernel_launch: occupancy query says %d\n", per_cu); per_cu = 1; }
        (void)hipGetLastError();
        grid = cus * (per_cu > 1 ? 1 : per_cu);
        fprintf(stderr, "kernel_launch: grid %d (cus %d, per_cu %d)\n", grid, cus, per_cu);
    }
    if (grid < 0) return;
    Args a{};
    for (int i = 0; i < 38; ++i) a.in[i] = (const float*)d_in[i];
    a.out = (float*)d_out; a.ws = (unsigned char*)d_ws;
#if MK_PER_PHASE_LAUNCH
    for (int p = 0; p < N_PHASES; ++p) {
        a.ph_lo = p; a.ph_hi = p + 1;
        hipLaunchKernelGGL(fwd_megakernel, dim3(grid), dim3(512), LDS_BYTES, stream, a);
    }
#else
    a.ph_lo = 0; a.ph_hi = N_PHASES;
    void* kargs[] = {&a};
    hipError_t e = hipLaunchCooperativeKernel((const void*)fwd_megakernel, dim3(grid), dim3(512), kargs, LDS_BYTES, stream);
    if (e != hipSuccess) fprintf(stderr, "kernel_launch: cooperative launch failed: %s (grid %d)\n", hipGetErrorString(e), grid);
#endif
}
```

```cpp
#include <hip/hip_runtime.h>
#include <hip/hip_cooperative_groups.h>
#include <cstdio>
#include <cstdint>
namespace cg = cooperative_groups;

#ifndef MK_PER_PHASE_LAUNCH
#define MK_PER_PHASE_LAUNCH 0
#endif

#define LAS __attribute__((address_space(3)))
typedef unsigned short bf16_t;
typedef short bf16x8 __attribute__((ext_vector_type(8)));
typedef float f32x4 __attribute__((ext_vector_type(4)));
typedef float f32x2 __attribute__((ext_vector_type(2)));
typedef unsigned u32x4 __attribute__((ext_vector_type(4)));
typedef unsigned u32x2 __attribute__((ext_vector_type(2)));

constexpr int DM = 2048, NB = 4, SEQ = 2048, DB = 128, DT = 4;
constexpr int MP = NB * SEQ, MS = DB * DT, MT = MP + MS;
constexpr int DPOOL = 1024, DSSM = 1024, PBUF = 15, NG = 64, NST = 64, CH = 16;
constexpr int NMEM = 256, NH = 4, HD = 512, DFF = 5632;
constexpr float ALPHA = 1.189207115002721f;
constexpr float LN_EPS = 1e-5f;
constexpr float QSCALE = 0.04419417382415922f;

constexpr size_t O_Y = 0;
constexpr size_t O_PPOOL = (size_t)MT * DM;
constexpr size_t O_PRE = O_PPOOL + (size_t)NB * PBUF * DPOOL;
constexpr size_t O_PIM = O_PRE + (size_t)NB * NG * NST;
constexpr size_t O_PCONV = O_PIM + (size_t)NB * NG * NST;
constexpr size_t O_PMK = O_PCONV + (size_t)NB * 2 * DFF;
constexpr size_t O_PMV = O_PMK + (size_t)NB * NMEM * DM;
constexpr size_t O_SPOOL = O_PMV + (size_t)NB * NMEM * DM;
constexpr size_t O_SRE = O_SPOOL + (size_t)DB * PBUF * DPOOL;
constexpr size_t O_SIM = O_SRE + (size_t)DB * NG * NST;
constexpr size_t O_SCONV = O_SIM + (size_t)DB * NG * NST;
constexpr size_t O_END = O_SCONV + (size_t)DB * 2 * DFF;

constexpr size_t MiB = 1u << 20;
constexpr size_t WS_WIN = 1 * MiB;
constexpr size_t WS_WKV = WS_WIN + 8 * MiB;
constexpr size_t WS_WPOOL = WS_WKV + 16 * MiB;
constexpr size_t WS_WGLU = WS_WPOOL + 1 * MiB;
constexpr size_t WS_WOUT = WS_WGLU + 2 * MiB;
constexpr size_t WS_WQ = WS_WOUT + 8 * MiB;
constexpr size_t WS_WO = WS_WQ + 8 * MiB;
constexpr size_t WS_WGU = WS_WO + 8 * MiB;
constexpr size_t WS_WDOWN = WS_WGU + 44 * MiB;
constexpr size_t WS_SSMT = WS_WDOWN + 22 * MiB;
constexpr size_t WS_XB = WS_SSMT + 1 * MiB;
constexpr size_t WS_MEMB = WS_XB + 34 * MiB;
constexpr size_t WS_U = WS_MEMB + 4 * MiB;
constexpr size_t WS_POOLED = WS_U + 68 * MiB;
constexpr size_t WS_Z = WS_POOLED + 17 * MiB;
constexpr size_t WS_MIX = WS_Z + 17 * MiB;
constexpr size_t WS_PRE = WS_MIX + 34 * MiB;
constexpr size_t WS_H1 = WS_PRE + 68 * MiB;
constexpr size_t WS_H2 = WS_H1 + 68 * MiB;
constexpr size_t WS_HB = WS_H2 + 68 * MiB;
constexpr size_t WS_Q = WS_HB + 34 * MiB;
constexpr size_t WS_KB = WS_Q + 34 * MiB;
constexpr size_t WS_VT = WS_KB + 8 * MiB;
constexpr size_t WS_S = WS_VT + 4 * MiB;
constexpr size_t WS_P = WS_S + 32 * MiB;
constexpr size_t WS_AO = WS_P + 16 * MiB;
constexpr size_t WS_GU = WS_AO + 34 * MiB;
constexpr size_t WS_ACT = WS_GU + 187 * MiB;
constexpr size_t WS_END = WS_ACT + 94 * MiB;
constexpr size_t ST_BOP = 0;
constexpr size_t ST_COP = 512 * 1024;
constexpr size_t ST_LAM = 768 * 1024;

constexpr int LDS_BYTES = 147456;

__device__ __forceinline__ unsigned f2bf(float f) { unsigned u = __builtin_bit_cast(unsigned, f); return (u + 0x7fffu + ((u >> 16) & 1u)) >> 16; }
__device__ __forceinline__ unsigned pk2(float lo, float hi) { return f2bf(lo) | (f2bf(hi) << 16); }
__device__ __forceinline__ float bf2f(unsigned h) { return __builtin_bit_cast(float, h << 16); }
__device__ __forceinline__ float wave_sum(float v) {
#pragma unroll
    for (int o = 1; o < 64; o <<= 1) v += __shfl_xor(v, o);
    return v;
}
__device__ __forceinline__ float wave_max(float v) {
#pragma unroll
    for (int o = 1; o < 64; o <<= 1) v = fmaxf(v, __shfl_xor(v, o));
    return v;
}

namespace pg8 {
constexpr int BM = 256, BK = 64, HALF = 128, HTB = HALF * BK * 2, STAGE_BYTES = 8 * HTB, NXCD = 8, WGM = 8;
__device__ __forceinline__ int lds_byte(int r, int c) { const int st = (r >> 4) * 2 + (c >> 5), rr = r & 15, cc = c & 31, ob = rr * 64 + cc * 2; return st * 1024 + (ob ^ (((ob >> 9) & 1) << 5)); }
__device__ __forceinline__ void stage_rc(int b, int& R, int& C) { const int st = b / 1024, sb = b % 1024, swz = sb ^ (((sb >> 9) & 1) << 5); R = (st >> 1) * 16 + swz / 64; C = (st & 1) * 32 + (swz % 64) / 2; }
__device__ __forceinline__ int perm32(int rho) { const int n = rho >> 4, i = rho & 15; return 8 * (i >> 2) + 4 * n + (i & 3); }

struct Unit { const char* a; const char* b; int row0, col0; };
struct Dims { int lda, ldb, K; };

struct GridSched {
    const char* A; const char* B; long a_pm, a_pn, b_pn; int nM, nN, nwg, G, c;
    __device__ __forceinline__ bool next(int i, Unit& u) const {
        const long L = (long)i * G + c; if (L >= nwg) return false;
        int wgid = (int)L; { const int q = nwg / NXCD, r = nwg % NXCD, xcd = wgid % NXCD, off = wgid / NXCD; wgid = (xcd < r ? xcd * (q + 1) : r * (q + 1) + (xcd - r) * q) + off; }
        const int nig = WGM * nN, gid = wgid / nig, fm = gid * WGM, gsz = (nM - fm) < WGM ? (nM - fm) : WGM;
        const int pm = fm + ((wgid % nig) % gsz), pn = (wgid % nig) / gsz;
        u.a = A + pm * a_pm + pn * a_pn; u.b = B + pn * b_pn; u.row0 = pm * BM; u.col0 = pn * BM; return true;
    }
};

template <class Epi, class Sched>
__device__ __forceinline__ void gemm_phase(LAS unsigned char* lds, const Dims g, const Sched& S, const Epi& E) {
    const int tid = threadIdx.x, wid = __builtin_amdgcn_readfirstlane(tid >> 6), lane = tid & 63, wr = wid >> 2, wc = wid & 3, fr = lane & 15, fq = lane >> 4;
    const int K = g.K, nt = K / BK;
    unsigned voffA[2], voffB[2];
#pragma unroll
    for (int i = 0; i < 2; ++i) { int R, C; stage_rc(tid * 16 + i * 8192, R, C); const int Rb = (R & ~31) + perm32(R & 31);
        voffA[i] = (unsigned)(R * g.lda + C) * 2u; voffB[i] = (unsigned)(Rb * g.ldb + C) * 2u; }
    const size_t kstep = (size_t)(BK * 2);
    const size_t hstepA = (size_t)HALF * g.lda * 2, hstepB = (size_t)HALF * g.ldb * 2;
    const unsigned ldsw = (unsigned)wid * 1024u;
    const int aoff = lds_byte(wr * 64 + fr, fq * 8), boff = lds_byte(wc * 32 + fr, fq * 8);
#define PG8_SA(b, h) (((b) * 2 + (h)) * HTB)
#define PG8_SB(b, h) ((4 + (b) * 2 + (h)) * HTB)
#define PG8_STAGE(bufoff, gbase, voff) do { _Pragma("unroll") for (int _i = 0; _i < 2; ++_i) \
        __builtin_amdgcn_global_load_lds((const unsigned*)((const char*)(gbase) + (voff)[_i]), (LAS unsigned*)(lds + (bufoff) + ldsw + _i * 8192), 16, 0, 0); } while (0)
#define PG8_LDA(dst, b, h) do { _Pragma("unroll") for (int m = 0; m < 4; ++m) _Pragma("unroll") for (int k = 0; k < 2; ++k) dst[m][k] = *(const LAS bf16x8*)(lds + PG8_SA(b, h) + aoff + m * 2048 + k * 1024); } while (0)
#define PG8_LDB(dst, b, h) do { _Pragma("unroll") for (int n = 0; n < 2; ++n) _Pragma("unroll") for (int k = 0; k < 2; ++k) dst[n][k] = *(const LAS bf16x8*)(lds + PG8_SB(b, h) + boff + n * 2048 + k * 1024); } while (0)
#define PG8_MMA(ai, bj, At, Bt) do { __builtin_amdgcn_s_setprio(1); _Pragma("unroll") for (int m = 0; m < 4; ++m) _Pragma("unroll") for (int n = 0; n < 2; ++n) _Pragma("unroll") for (int k = 0; k < 2; ++k) \
        acc[ai][bj][m][n] = __builtin_amdgcn_mfma_f32_16x16x32_bf16(Bt[n][k], At[m][k], acc[ai][bj][m][n], 0, 0, 0); __builtin_amdgcn_s_setprio(0); } while (0)
#define PG8_WAIT_V(n) asm volatile("s_waitcnt vmcnt(" #n ")" ::: "memory")
#define PG8_WAIT_L(n) asm volatile("s_waitcnt lgkmcnt(" #n ")" ::: "memory")
#define PG8_BAR __builtin_amdgcn_s_barrier()
#define PG8_SCHED __builtin_amdgcn_sched_barrier(0)
    Unit cur, nxt; int ui = 0;
    if (!S.next(0, cur)) return;
    f32x4 acc[2][2][4][2];
#pragma unroll
    for (int a = 0; a < 2; ++a)
#pragma unroll
        for (int b = 0; b < 2; ++b)
#pragma unroll
            for (int m = 0; m < 4; ++m)
#pragma unroll
                for (int n = 0; n < 2; ++n) acc[a][b][m][n] = (f32x4){0.f, 0.f, 0.f, 0.f};
    bf16x8 At[4][2], B0[2][2], B1[2][2];
    const char* cA = cur.a; const char* cB = cur.b;
    PG8_STAGE(PG8_SB(0, 0), cB, voffB); PG8_STAGE(PG8_SB(0, 1), cB + hstepB, voffB); PG8_STAGE(PG8_SA(0, 0), cA, voffA); PG8_STAGE(PG8_SA(0, 1), cA + hstepA, voffA);
    if (wr == 1) PG8_BAR;
    PG8_WAIT_V(2); PG8_BAR;
    PG8_STAGE(PG8_SB(1, 0), cB + kstep, voffB); PG8_STAGE(PG8_SA(1, 0), cA + kstep, voffA); PG8_STAGE(PG8_SB(1, 1), cB + hstepB + kstep, voffB);
    PG8_WAIT_V(6); PG8_BAR;
    for (;;) {
        const bool has_next = S.next(ui + 1, nxt);
        const char* nA = has_next ? nxt.a : cA; const char* nB = has_next ? nxt.b : cB;
        for (int t = 0; t < nt; t += 2) {
            const bool last = (t == nt - 2);
            const char* a1 = cA + (size_t)(t + 1) * kstep;
            const char* a2 = last ? nA : cA + (size_t)(t + 2) * kstep; const char* b2 = last ? nB : cB + (size_t)(t + 2) * kstep;
            const char* a3 = a2 + kstep; const char* b3 = b2 + kstep;
            PG8_LDB(B0, 0, 0); PG8_LDB(B1, 0, 1); PG8_SCHED; PG8_LDA(At, 0, 0); PG8_STAGE(PG8_SA(1, 1), a1 + hstepA, voffA);
            PG8_WAIT_V(8); PG8_WAIT_L(0); PG8_BAR; PG8_MMA(0, 0, At, B0); PG8_MMA(0, 1, At, B1); PG8_BAR; PG8_SCHED;
            PG8_LDA(At, 0, 1); PG8_STAGE(PG8_SB(0, 0), b2, voffB); PG8_STAGE(PG8_SB(0, 1), b2 + hstepB, voffB); PG8_STAGE(PG8_SA(0, 0), a2, voffA);
            PG8_WAIT_V(8); PG8_WAIT_L(0); PG8_BAR; PG8_MMA(1, 0, At, B0); PG8_MMA(1, 1, At, B1); PG8_BAR; PG8_SCHED;
            PG8_LDB(B0, 1, 0); PG8_LDB(B1, 1, 1); PG8_SCHED; PG8_LDA(At, 1, 0); PG8_STAGE(PG8_SA(0, 1), a2 + hstepA, voffA);
            PG8_WAIT_V(8); PG8_WAIT_L(0); PG8_BAR; PG8_MMA(0, 0, At, B0); PG8_MMA(0, 1, At, B1); PG8_BAR; PG8_SCHED;
            PG8_LDA(At, 1, 1); PG8_STAGE(PG8_SB(1, 0), b3, voffB); PG8_STAGE(PG8_SB(1, 1), b3 + hstepB, voffB); PG8_STAGE(PG8_SA(1, 0), a3, voffA);
            PG8_WAIT_V(8); PG8_WAIT_L(0); PG8_BAR; PG8_MMA(1, 0, At, B0); PG8_MMA(1, 1, At, B1); PG8_BAR; PG8_SCHED;
        }
        if (wr == 0) PG8_BAR;
        E(acc, cur, wr, wc, fr, fq);
        if (!has_next) break;
#pragma unroll
        for (int a = 0; a < 2; ++a)
#pragma unroll
            for (int b = 0; b < 2; ++b)
#pragma unroll
                for (int m = 0; m < 4; ++m)
#pragma unroll
                    for (int n = 0; n < 2; ++n) acc[a][b][m][n] = (f32x4){0.f, 0.f, 0.f, 0.f};
        cur = nxt; cA = nA; cB = nB; ++ui;
        if (wr == 1) PG8_BAR;
    }
    PG8_WAIT_V(0);
    PG8_BAR;
#undef PG8_SA
#undef PG8_SB
#undef PG8_STAGE
#undef PG8_LDA
#undef PG8_LDB
#undef PG8_MMA
#undef PG8_WAIT_V
#undef PG8_WAIT_L
#undef PG8_BAR
#undef PG8_SCHED
}

typedef const f32x4 (&AccRef)[2][2][4][2];

struct EpiStore {
    float* F; bf16_t* Bo; int ld; int split_cols; size_t split_stride; float scale; const float* colscale;
    __device__ __forceinline__ void operator()(AccRef acc, const Unit& u, int wr, int wc, int fr, int fq) const {
        int colt = u.col0; size_t soff = 0;
        if (split_cols) { const int t = colt / split_cols; soff = (size_t)t * split_stride; colt -= t * split_cols; }
        const int col0 = colt + wc * 32 + 8 * fq, row0 = u.row0 + wr * 64 + fr;
        f32x4 cs[2][2];
#pragma unroll
        for (int bj = 0; bj < 2; ++bj)
#pragma unroll
            for (int n = 0; n < 2; ++n) { cs[bj][n] = colscale ? *(const f32x4*)(colscale + col0 + bj * HALF + 4 * n) : (f32x4){1.f, 1.f, 1.f, 1.f}; cs[bj][n] = cs[bj][n] * scale; }
#pragma unroll
        for (int ai = 0; ai < 2; ++ai)
#pragma unroll
            for (int m = 0; m < 4; ++m) {
                const size_t off = soff + (size_t)(row0 + ai * HALF + m * 16) * ld + col0;
#pragma unroll
                for (int bj = 0; bj < 2; ++bj) {
                    const f32x4 v0 = acc[ai][bj][m][0] * cs[bj][0], v1 = acc[ai][bj][m][1] * cs[bj][1];
                    if (F) { *(f32x4*)(F + off + bj * HALF) = v0; *(f32x4*)(F + off + bj * HALF + 4) = v1; }
                    if (Bo) { u32x4 w; w.x = pk2(v0[0], v0[1]); w.y = pk2(v0[2], v0[3]); w.z = pk2(v1[0], v1[1]); w.w = pk2(v1[2], v1[3]); *(u32x4*)(Bo + off + bj * HALF) = w; }
                }
            }
    }
};

struct EpiGlu {
    const bf16_t* Z; const float* bias; bf16_t* O;
    __device__ __forceinline__ void operator()(AccRef acc, const Unit& u, int wr, int wc, int fr, int fq) const {
        const int col0 = u.col0 + wc * 32 + 8 * fq, row0 = u.row0 + wr * 64 + fr;
        f32x4 bv[2][2];
#pragma unroll
        for (int bj = 0; bj < 2; ++bj)
#pragma unroll
            for (int n = 0; n < 2; ++n) bv[bj][n] = *(const f32x4*)(bias + col0 + bj * HALF + 4 * n);
#pragma unroll
        for (int ai = 0; ai < 2; ++ai)
#pragma unroll
            for (int m = 0; m < 4; ++m) {
                const size_t row = (size_t)(row0 + ai * HALF + m * 16);
#pragma unroll
                for (int bj = 0; bj < 2; ++bj) {
                    const u32x4 zz = *(const u32x4*)(Z + row * DSSM + col0 + bj * HALF);
                    const f32x4 a0 = acc[ai][bj][m][0] + bv[bj][0], a1 = acc[ai][bj][m][1] + bv[bj][1];
                    float o[8];
#pragma unroll
                    for (int e = 0; e < 8; ++e) {
                        const unsigned zw = (e < 2) ? zz.x : (e < 4) ? zz.y : (e < 6) ? zz.z : zz.w;
                        const float zf = (e & 1) ? bf2f(zw >> 16) : bf2f(zw & 0xffffu);
                        const float av = (e < 4) ? a0[e & 3] : a1[e & 3];
                        o[e] = zf / (1.f + __expf(-av));
                    }
                    u32x4 w; w.x = pk2(o[0], o[1]); w.y = pk2(o[2], o[3]); w.z = pk2(o[4], o[5]); w.w = pk2(o[6], o[7]);
                    *(u32x4*)(O + row * DM + DPOOL + col0 + bj * HALF) = w;
                }
            }
    }
};

struct EpiResid {
    const float* res0; const float* res1; float* O;
    __device__ __forceinline__ void operator()(AccRef acc, const Unit& u, int wr, int wc, int fr, int fq) const {
        const int col0 = u.col0 + wc * 32 + 8 * fq, row0 = u.row0 + wr * 64 + fr;
        const float* rb = (u.row0 < MP) ? res0 : (res1 - (size_t)MP * DM);
#pragma unroll
        for (int ai = 0; ai < 2; ++ai)
#pragma unroll
            for (int m = 0; m < 4; ++m) {
                const size_t off = (size_t)(row0 + ai * HALF + m * 16) * DM + col0;
#pragma unroll
                for (int bj = 0; bj < 2; ++bj) {
                    const f32x4 r0 = *(const f32x4*)(rb + off + bj * HALF), r1 = *(const f32x4*)(rb + off + bj * HALF + 4);
                    *(f32x4*)(O + off + bj * HALF) = r0 * ALPHA + acc[ai][bj][m][0];
                    *(f32x4*)(O + off + bj * HALF + 4) = r1 * ALPHA + acc[ai][bj][m][1];
                }
                if (m & 1) asm volatile("" ::: "memory");
            }
    }
};

struct EpiGateUp {
    bf16_t* O; float* pconv; float* sconv;
    __device__ __forceinline__ void operator()(AccRef acc, const Unit& u, int wr, int wc, int fr, int fq) const {
        const int col0 = u.col0 + wc * 32 + 8 * fq, row0 = u.row0 + wr * 64 + fr;
        const bool gate = u.col0 < DFF;
#pragma unroll
        for (int ai = 0; ai < 2; ++ai)
#pragma unroll
            for (int m = 0; m < 4; ++m) {
                const int row = row0 + ai * HALF + m * 16;
                const size_t off = (size_t)row * (2 * DFF) + col0;
                float* st = nullptr;
                if (gate) {
                    if (row < MP) { const int t = row & (SEQ - 1); if (t >= SEQ - 2) st = pconv + ((size_t)(row >> 11) * 2 + (t - (SEQ - 2))) * DFF; }
                    else { const int r = row - MP, t = r & 3; if (t >= 2) st = sconv + ((size_t)(r >> 2) * 2 + (t - 2)) * DFF; }
                }
#pragma unroll
                for (int bj = 0; bj < 2; ++bj) {
                    const f32x4 v0 = acc[ai][bj][m][0], v1 = acc[ai][bj][m][1];
                    u32x4 w; w.x = pk2(v0[0], v0[1]); w.y = pk2(v0[2], v0[3]); w.z = pk2(v1[0], v1[1]); w.w = pk2(v1[2], v1[3]);
                    *(u32x4*)(O + off + bj * HALF) = w;
                    if (st) { *(f32x4*)(st + col0 + bj * HALF) = v0; *(f32x4*)(st + col0 + bj * HALF + 4) = v1; }
                }
            }
    }
};

struct SchedS {
    const char* Q; const char* Kb; int G, c;
    __device__ __forceinline__ bool next(int i, Unit& u) const {
        const int L = i * G + c; if (L >= 128) return false;
        const int z = L >> 3, pm = L & 7, b = z >> 2, h = z & 3;
        u.a = Q + ((size_t)(b * SEQ + pm * 256) * DM + h * HD) * 2; u.b = Kb + ((size_t)(b * NMEM) * DM + h * HD) * 2;
        u.row0 = z * SEQ + pm * 256; u.col0 = 0; return true;
    }
};
struct SchedPV {
    const char* P; const char* Vt; int G, c;
    __device__ __forceinline__ bool next(int i, Unit& u) const {
        const int L = i * G + c; if (L >= 256) return false;
        const int pn = L & 1, pm = (L >> 1) & 7, z = L >> 4, b = z >> 2, h = z & 3;
        u.a = P + ((size_t)(z * SEQ + pm * 256) * NMEM) * 2; u.b = Vt + ((size_t)(h * HD + pn * 256) * (NB * NMEM) + b * NMEM) * 2;
        u.row0 = b * SEQ + pm * 256; u.col0 = h * HD + pn * 256; return true;
    }
};
}

#define XB_TMO      128
#define XB_XCNT(j)  (256  + 64 * (j))
#define XB_XSUB(j)  (1280 + 64 * (j))
#define XB_XGEN(j)  (2304 + 64 * (j))
#define XB_TOP      3328
#define XB_TOPGEN   3392
#define XCD_BAR_WORDS 3456
#define XB_SPIN_CAP (1u << 18)

__device__ __forceinline__ unsigned xb_ld(unsigned* p)              { return __hip_atomic_load(p, __ATOMIC_RELAXED, __HIP_MEMORY_SCOPE_AGENT); }
__device__ __forceinline__ unsigned xb_add(unsigned* p, unsigned v) { return __hip_atomic_fetch_add(p, v, __ATOMIC_RELAXED, __HIP_MEMORY_SCOPE_AGENT); }
__device__ __forceinline__ unsigned xb_xcc_id() { return (unsigned)__builtin_amdgcn_s_getreg((3 << 11) | 20) & 0xFu; }
#define XB_SPIN(cond, bar) do { unsigned _sp = 0; while (cond) { __builtin_amdgcn_s_sleep(1); \
    if ((++_sp & 255u) == 0u) { if (xb_ld(&(bar)[XB_TMO])) break; if (_sp > XB_SPIN_CAP) { atomicAdd(&(bar)[XB_TMO], 1u); break; } } } } while (0)

struct XcdBarrier {
    unsigned* bar; unsigned x;
    volatile LAS unsigned* st;
};

__device__ __forceinline__ XcdBarrier xcd_barrier_post(unsigned* bar, volatile LAS unsigned* st) {
    XcdBarrier b; b.bar = bar; b.x = xb_xcc_id(); b.st = st;
    if (threadIdx.x == 0) (void)xb_add(&bar[XB_XCNT(b.x)], 1u);
    return b;
}
__device__ __forceinline__ void xcd_barrier_complete(unsigned* bar, unsigned x, unsigned& nloc, unsigned& nx) {
    const unsigned G = gridDim.x * gridDim.y * gridDim.z;
    unsigned sum, cnt, mine, sp = 0u;
    for (;;) {
        sum = 0u; cnt = 0u; mine = 0u;
#pragma unroll
        for (unsigned j = 0; j < 16; ++j) { const unsigned c = xb_ld(&bar[XB_XCNT(j)]); sum += c; cnt += (c > 0u) ? 1u : 0u; mine = (j == x) ? c : mine; }
        if (sum == G) break;
        __builtin_amdgcn_s_sleep(1);
        if ((++sp & 255u) == 0u) { if (xb_ld(&bar[XB_TMO])) break; if (sp > XB_SPIN_CAP) { atomicAdd(&bar[XB_TMO], 1u); break; } }
    }
    nloc = mine > 0u ? mine : 1u; nx = cnt > 0u ? cnt : 1u;
}

__device__ __forceinline__ void xcd_barrier(const XcdBarrier& b) {
    asm volatile("s_waitcnt vmcnt(0)" ::: "memory");
    __syncthreads();
    if (threadIdx.x == 0) {
        unsigned* bar = b.bar;
        __builtin_amdgcn_s_waitcnt(0);
        unsigned nloc = b.st[0], nx = b.st[1];
        if (nloc == 0u) { xcd_barrier_complete(bar, b.x, nloc, nx); b.st[0] = nloc; b.st[1] = nx; }
        const unsigned old = xb_add(&bar[XB_XSUB(b.x)], 1u);
        const unsigned gen = old / nloc;
        if (old + 1u == (gen + 1u) * nloc) {
            __builtin_amdgcn_fence(__ATOMIC_RELEASE, "agent");
            asm volatile("s_waitcnt vmcnt(0)" ::: "memory");
            const unsigned og = xb_add(&bar[XB_TOP], 1u);
            const unsigned tg = og / nx;
            if (og + 1u == (tg + 1u) * nx) xb_add(&bar[XB_TOPGEN], 1u);
            else XB_SPIN(xb_ld(&bar[XB_TOPGEN]) == tg, bar);
            __builtin_amdgcn_fence(__ATOMIC_ACQUIRE, "agent");
            xb_add(&bar[XB_XGEN(b.x)], 1u);
            asm volatile("s_waitcnt vmcnt(0)" ::: "memory");
        } else {
            XB_SPIN(xb_ld(&bar[XB_XGEN(b.x)]) == gen, bar);
            __builtin_amdgcn_fence(__ATOMIC_ACQUIRE, "agent");
            asm volatile("s_waitcnt vmcnt(0)" ::: "memory");
        }
    }
    __syncthreads();
}


struct Args { const float* in[38]; float* out; unsigned char* ws; int ph_lo, ph_hi; };
#define CAS __attribute__((address_space(4)))
typedef const CAS Args* ArgP;
__device__ __forceinline__ int lane_id() { int l = threadIdx.x & 63; asm volatile("" : "+v"(l)); return l; }
__device__ __forceinline__ int wave_id() { int t = threadIdx.x; asm volatile("" : "+v"(t)); return __builtin_amdgcn_readfirstlane(t >> 6); }
__device__ __forceinline__ ArgP argp() { ArgP p = (ArgP)__builtin_amdgcn_kernarg_segment_ptr(); asm volatile("" : "+s"(p)); return p; }

__device__ __forceinline__ void transpose_item(const float* W, int K, int N, bf16_t* WT, int row_off, LAS float* scr, int item, int lane) {
    const int nblk = N / 32, kb = item / nblk, nb = item % nblk, k0 = 64 * kb, n0 = 32 * nb;
#pragma unroll 8
    for (int i = 0; i < 32; ++i) { const int kk = 2 * i + (lane >> 5); scr[kk * 33 + (lane & 31)] = W[(size_t)(k0 + kk) * N + n0 + (lane & 31)]; }
    asm volatile("s_waitcnt lgkmcnt(0)" ::: "memory");
    const int c = lane & 7;
#pragma unroll
    for (int j = 0; j < 4; ++j) { const int n = (lane >> 3) + 8 * j; const LAS float* s = scr + (8 * c) * 33 + n;
        u32x4 o; o.x = pk2(s[0 * 33], s[1 * 33]); o.y = pk2(s[2 * 33], s[3 * 33]); o.z = pk2(s[4 * 33], s[5 * 33]); o.w = pk2(s[6 * 33], s[7 * 33]);
        *(u32x4*)(WT + (size_t)(row_off + n0 + n) * K + k0 + 8 * c) = o; }
    asm volatile("s_waitcnt lgkmcnt(0)" ::: "memory");
}

__device__ __forceinline__ void cvt_rows(const float* src, bf16_t* dst, size_t n8, size_t gtid, size_t nthr) {
    for (size_t i = gtid; i < n8; i += nthr) {
        const f32x4 a = *(const f32x4*)(src + i * 8), b = *(const f32x4*)(src + i * 8 + 4);
        u32x4 w; w.x = pk2(a[0], a[1]); w.y = pk2(a[2], a[3]); w.z = pk2(b[0], b[1]); w.w = pk2(b[2], b[3]);
        *(u32x4*)(dst + i * 8) = w;
    }
}

__device__ __forceinline__ void phase_prep(LAS unsigned char* lds) {
    const int lane = lane_id(), wave = wave_id();
    ArgP A = argp(); unsigned char* ws = A->ws;
    const int G = gridDim.x, gw = blockIdx.x * 8 + wave, NGW = G * 8;
    LAS float* scr = (LAS float*)(lds + wave * 16384);
    constexpr int I_SQ = 2048, I_POOL = 32, I_GLU = 512, I_FF = 5632;
    constexpr int NITEMS = 3 * I_FF + 6 * I_SQ + I_GLU + 4 * I_POOL;
    for (int it = gw; it < NITEMS; it += NGW) {
        int r = it;
        if (r < I_FF) { transpose_item(A->in[31], DM, DFF, (bf16_t*)(ws + WS_WGU), 0, scr, r, lane); continue; } r -= I_FF;
        if (r < I_FF) { transpose_item(A->in[32], DM, DFF, (bf16_t*)(ws + WS_WGU), DFF, scr, r, lane); continue; } r -= I_FF;
        if (r < I_FF) { transpose_item(A->in[35], DFF, DM, (bf16_t*)(ws + WS_WDOWN), 0, scr, r, lane); continue; } r -= I_FF;
        if (r < I_SQ) { transpose_item(A->in[9], DM, DM, (bf16_t*)(ws + WS_WIN), 0, scr, r, lane); continue; } r -= I_SQ;
        if (r < I_SQ) { transpose_item(A->in[26], DM, DM, (bf16_t*)(ws + WS_WKV), 0, scr, r, lane); continue; } r -= I_SQ;
        if (r < I_SQ) { transpose_item(A->in[27], DM, DM, (bf16_t*)(ws + WS_WKV), DM, scr, r, lane); continue; } r -= I_SQ;
        if (r < I_SQ) { transpose_item(A->in[22], DM, DM, (bf16_t*)(ws + WS_WOUT), 0, scr, r, lane); continue; } r -= I_SQ;
        if (r < I_SQ) { transpose_item(A->in[25], DM, DM, (bf16_t*)(ws + WS_WQ), 0, scr, r, lane); continue; } r -= I_SQ;
        if (r < I_SQ) { transpose_item(A->in[28], DM, DM, (bf16_t*)(ws + WS_WO), 0, scr, r, lane); continue; } r -= I_SQ;
        if (r < I_GLU) { transpose_item(A->in[20], DSSM, DSSM, (bf16_t*)(ws + WS_WGLU), 0, scr, r, lane); continue; } r -= I_GLU;
        { const int g = r / I_POOL; transpose_item(A->in[10] + (size_t)g * 65536, 256, 256, (bf16_t*)(ws + WS_WPOOL) + (size_t)g * 65536, 0, scr, r % I_POOL, lane); }
    }
    const size_t gtid = (size_t)blockIdx.x * 512 + threadIdx.x, nthr = (size_t)G * 512;
    cvt_rows(A->in[0], (bf16_t*)(ws + WS_XB), (size_t)MP * DM / 8, gtid, nthr);
    cvt_rows(A->in[1], (bf16_t*)(ws + WS_XB) + (size_t)MP * DM, (size_t)MS * DM / 8, gtid, nthr);
    cvt_rows(A->in[2], (bf16_t*)(ws + WS_MEMB), (size_t)NB * NMEM * DM / 8, gtid, nthr);
    const float* lre = A->in[12]; const float* lim = A->in[13]; const float* lstep = A->in[14];
    const float* bre = A->in[15]; const float* bim = A->in[16]; const float* cre = A->in[17]; const float* cim = A->in[18];
    unsigned char* st = ws + WS_SSMT;
    for (size_t i = gtid; i < (size_t)NG * NST; i += nthr) {
        const int g = (int)(i >> 6), n = (int)(i & 63);
        const float dt = expf(lstep[g]);
        const float ar = lre[i], ai = lim[i];
        const float er = expf(ar * dt); float sn, cs; sincosf(ai * dt, &sn, &cs);
        const float br = er * cs, bi = er * sn;
        ((float*)(st + ST_LAM))[2 * i] = br; ((float*)(st + ST_LAM))[2 * i + 1] = bi;
        const float nr = br - 1.f, ni = bi, den = ar * ar + ai * ai;
        const float fr_ = (nr * ar + ni * ai) / den, fi_ = (ni * ar - nr * ai) / den;
        float pr[16], pi[16];
#pragma unroll
        for (int c = 0; c < 16; ++c) { const float x = bre[i * 16 + c], y = bim[i * 16 + c]; pr[c] = fr_ * x - fi_ * y; pi[c] = fr_ * y + fi_ * x; }
        u32x4* bop = (u32x4*)(st + ST_BOP) + (size_t)g * 8 * 64;
        const int blk = n >> 4, l16 = n & 15;
        u32x4 w;
        w.x = pk2(pr[0], pr[1]); w.y = pk2(pr[2], pr[3]); w.z = pk2(pr[4], pr[5]); w.w = pk2(pr[6], pr[7]); bop[(blk) * 64 + 0 * 16 + l16] = w;
        w.x = pk2(pr[8], pr[9]); w.y = pk2(pr[10], pr[11]); w.z = pk2(pr[12], pr[13]); w.w = pk2(pr[14], pr[15]); bop[(blk) * 64 + 1 * 16 + l16] = w;
        w.x = pk2(pi[0], pi[1]); w.y = pk2(pi[2], pi[3]); w.z = pk2(pi[4], pi[5]); w.w = pk2(pi[6], pi[7]); bop[(4 + blk) * 64 + 0 * 16 + l16] = w;
        w.x = pk2(pi[8], pi[9]); w.y = pk2(pi[10], pi[11]); w.z = pk2(pi[12], pi[13]); w.w = pk2(pi[14], pi[15]); bop[(4 + blk) * 64 + 1 * 16 + l16] = w;
        const u32x4 zz = (u32x4){0u, 0u, 0u, 0u};
        bop[(blk) * 64 + 2 * 16 + l16] = zz; bop[(blk) * 64 + 3 * 16 + l16] = zz; bop[(4 + blk) * 64 + 2 * 16 + l16] = zz; bop[(4 + blk) * 64 + 3 * 16 + l16] = zz;
    }
    for (size_t i = gtid; i < (size_t)NG * 4 * 64; i += nthr) {
        const int L = (int)(i & 63), kk = (int)((i >> 6) & 3), g = (int)(i >> 8);
        const int c = L & 15, q = L >> 4, k0 = 32 * kk + 8 * q;
        float v[8];
#pragma unroll
        for (int e = 0; e < 8; ++e) { const int k = k0 + e; v[e] = (k < 64) ? cre[((size_t)g * 16 + c) * 64 + k] : -cim[((size_t)g * 16 + c) * 64 + (k - 64)]; }
        u32x4 w; w.x = pk2(v[0], v[1]); w.y = pk2(v[2], v[3]); w.z = pk2(v[4], v[5]); w.w = pk2(v[6], v[7]);
        ((u32x4*)(st + ST_COP))[i] = w;
    }
}

__device__ __forceinline__ void phase_pool() {
    ArgP A = argp(); unsigned char* ws = A->ws; const float* U = (const float*)(ws + WS_U); bf16_t* PO = (bf16_t*)(ws + WS_POOLED);
    const size_t gtid = (size_t)blockIdx.x * 512 + threadIdx.x, nthr = (size_t)gridDim.x * 512;
    for (size_t it = gtid; it < (size_t)(MP / 16) * 256; it += nthr) {
        const int qd = (int)(it & 255), tb = (int)(it >> 8), ch = qd * 4, w = 2 << (ch >> 8);
        const int row0 = tb * 16, t0 = row0 & (SEQ - 1);
        const float* up = U + (size_t)row0 * DM + ch;
        f32x4 s = (f32x4){0.f, 0.f, 0.f, 0.f};
        for (int j = 1; j < w; ++j) if (t0 - j >= 0) s += *(const f32x4*)(up - (size_t)j * DM);
        for (int j = 0; j < 16; ++j) {
            const f32x4 x = *(const f32x4*)(up + (size_t)j * DM);
            s += x;
            const int t = t0 + j; const float inv = 1.f / (float)((t + 1 < w) ? (t + 1) : w);
            const f32x4 o = s * inv - x;
            u32x2 pk; pk.x = pk2(o[0], o[1]); pk.y = pk2(o[2], o[3]);
            *(u32x2*)(PO + (size_t)(row0 + j) * DPOOL + ch) = pk;
            if (t - w + 1 >= 0) s -= *(const f32x4*)(up + (size_t)(j - w + 1) * DM);
        }
    }
    const float* SP = A->in[3];
    for (size_t it = gtid; it < (size_t)DB * 256; it += nthr) {
        const int qd = (int)(it & 255), b = (int)(it >> 8), ch = qd * 4, w = 2 << (ch >> 8);
        const float* sp = SP + (size_t)b * PBUF * DPOOL + ch;
        const float* up = U + (size_t)(MP + b * 4) * DM + ch;
        f32x4 s = (f32x4){0.f, 0.f, 0.f, 0.f};
        for (int j = 1; j < w; ++j) s += *(const f32x4*)(sp + (size_t)(PBUF - j) * DPOOL);
        const float inv = 1.f / (float)w;
        for (int j = 0; j < 4; ++j) {
            const f32x4 x = *(const f32x4*)(up + (size_t)j * DM);
            s += x;
            const f32x4 o = s * inv - x;
            u32x2 pk; pk.x = pk2(o[0], o[1]); pk.y = pk2(o[2], o[3]);
            *(u32x2*)(PO + (size_t)(MP + b * 4 + j) * DPOOL + ch) = pk;
            const int e = 15 + j - w + 1;
            s -= (e < PBUF) ? *(const f32x4*)(sp + (size_t)e * DPOOL) : *(const f32x4*)(up + (size_t)(e - PBUF) * DM);
        }
    }
    float* out = A->out;
    for (size_t it = gtid; it < (size_t)NB * PBUF * 256; it += nthr) {
        const int qd = (int)(it & 255), r = (int)(it >> 8), b = r / PBUF, j = r % PBUF;
        *(f32x4*)(out + O_PPOOL + (size_t)r * DPOOL + qd * 4) = *(const f32x4*)(U + (size_t)(b * SEQ + SEQ - PBUF + j) * DM + qd * 4);
    }
    for (size_t it = gtid; it < (size_t)DB * PBUF * 256; it += nthr) {
        const int qd = (int)(it & 255), r = (int)(it >> 8), b = r / PBUF, j = r % PBUF;
        const f32x4 v = (j < PBUF - DT) ? *(const f32x4*)(SP + ((size_t)b * PBUF + j + DT) * DPOOL + qd * 4) : *(const f32x4*)(U + (size_t)(MP + b * 4 + (j - (PBUF - DT))) * DM + qd * 4);
        *(f32x4*)(out + O_SPOOL + (size_t)r * DPOOL + qd * 4) = v;
    }
}

constexpr int BU_LD = 132;
constexpr int HB_LD = 136;
constexpr int SSM_WAVE_LDS = 16 * BU_LD * 4 + 16 * HB_LD * 2;

__device__ __forceinline__ float gelu_tanh(float y) { const float t = 1.5957691216f * (y + 0.044715f * y * y * y); return y / (1.f + __expf(-t)); }

__device__ __forceinline__ void ssm_bu_tile(const float* U, int row0, int g, int lane, const bf16x8 (&Bop)[8], LAS float* bu) {
    const int l16 = lane & 15, q = lane >> 4;
    bf16x8 ub = (bf16x8){0, 0, 0, 0, 0, 0, 0, 0};
    if (q < 2) {
        const float* p = U + (size_t)(row0 + l16) * DM + DPOOL + g * CH + 8 * q;
        const f32x4 a = *(const f32x4*)p, b = *(const f32x4*)(p + 4);
        u32x4 w; w.x = pk2(a[0], a[1]); w.y = pk2(a[2], a[3]); w.z = pk2(b[0], b[1]); w.w = pk2(b[2], b[3]);
        ub = __builtin_bit_cast(bf16x8, w);
    }
#pragma unroll
    for (int blk = 0; blk < 8; ++blk) {
        const f32x4 d = __builtin_amdgcn_mfma_f32_16x16x32_bf16(Bop[blk], ub, (f32x4){0.f, 0.f, 0.f, 0.f}, 0, 0, 0);
        *(LAS f32x4*)(bu + l16 * BU_LD + 16 * blk + 4 * q) = d;
    }
}
__device__ __forceinline__ void ssm_y_tile(const float* U, const float* dskip, bf16_t* Z, int row0, int g, int lane, const bf16x8 (&Cop)[4], const LAS bf16_t* hb) {
    const int l16 = lane & 15, q = lane >> 4;
    f32x4 acc = (f32x4){0.f, 0.f, 0.f, 0.f};
#pragma unroll
    for (int kk = 0; kk < 4; ++kk) {
        const bf16x8 b = *(const LAS bf16x8*)(hb + l16 * HB_LD + 32 * kk + 8 * q);
        acc = __builtin_amdgcn_mfma_f32_16x16x32_bf16(Cop[kk], b, acc, 0, 0, 0);
    }
    const int row = row0 + l16, ch = g * CH + 4 * q;
    const f32x4 uu = *(const f32x4*)(U + (size_t)row * DM + DPOOL + ch), dk = *(const f32x4*)(dskip + ch);
    const f32x4 y = acc + dk * uu;
    u32x2 pk; pk.x = pk2(gelu_tanh(y[0]), gelu_tanh(y[1])); pk.y = pk2(gelu_tanh(y[2]), gelu_tanh(y[3]));
    *(u32x2*)(Z + (size_t)row * DSSM + ch) = pk;
}

__device__ __forceinline__ void phase_ssm(LAS unsigned char* lds) {
    const int lane = lane_id(), wave = wave_id();
    ArgP A = argp(); unsigned char* ws = A->ws; const float* U = (const float*)(ws + WS_U); bf16_t* Z = (bf16_t*)(ws + WS_Z);
    const unsigned char* st = ws + WS_SSMT; const float* dskip = A->in[19]; float* out = A->out;
    LAS float* bu = (LAS float*)(lds + wave * SSM_WAVE_LDS);
    LAS bf16_t* hb = (LAS bf16_t*)(lds + wave * SSM_WAVE_LDS + 16 * BU_LD * 4);
    LAS float* xs = (LAS float*)(lds + 8 * SSM_WAVE_LDS);
    for (int task = blockIdx.x; task < NB * NG; task += gridDim.x) {
        const int b = task >> 6, g = task & 63;
        bf16x8 Bop[8], Cop[4];
#pragma unroll
        for (int i = 0; i < 8; ++i) Bop[i] = *(const bf16x8*)(st + ST_BOP + ((size_t)(g * 8 + i) * 64 + lane) * 16);
#pragma unroll
        for (int i = 0; i < 4; ++i) Cop[i] = *(const bf16x8*)(st + ST_COP + ((size_t)(g * 4 + i) * 64 + lane) * 16);
        const float lr = ((const float*)(st + ST_LAM))[2 * (g * 64 + lane)], li = ((const float*)(st + ST_LAM))[2 * (g * 64 + lane) + 1];
        const int rowb = b * SEQ + wave * 256;
        float hr = 0.f, hi = 0.f;
        for (int tl = 0; tl < 16; ++tl) {
            ssm_bu_tile(U, rowb + tl * 16, g, lane, Bop, bu);
#pragma unroll
            for (int j = 0; j < 16; ++j) { const float br = bu[j * BU_LD + lane], bi = bu[j * BU_LD + 64 + lane];
                const float nr = lr * hr - li * hi + br, ni = lr * hi + li * hr + bi; hr = nr; hi = ni; }
        }
        xs[(wave * 64 + lane) * 2] = hr; xs[(wave * 64 + lane) * 2 + 1] = hi;
        __syncthreads();
        float pr = lr, pi = li;
#pragma unroll
        for (int s = 0; s < 8; ++s) { const float a = pr * pr - pi * pi, c = 2.f * pr * pi; pr = a; pi = c; }
        hr = 0.f; hi = 0.f;
        for (int w2 = 0; w2 < wave; ++w2) { const float sr = xs[(w2 * 64 + lane) * 2], si = xs[(w2 * 64 + lane) * 2 + 1];
            const float nr = pr * hr - pi * hi + sr, ni = pr * hi + pi * hr + si; hr = nr; hi = ni; }
        for (int tl = 0; tl < 16; ++tl) {
            ssm_bu_tile(U, rowb + tl * 16, g, lane, Bop, bu);
#pragma unroll
            for (int j = 0; j < 16; ++j) { const float br = bu[j * BU_LD + lane], bi = bu[j * BU_LD + 64 + lane];
                const float nr = lr * hr - li * hi + br, ni = lr * hi + li * hr + bi; hr = nr; hi = ni;
                hb[j * HB_LD + lane] = (bf16_t)f2bf(hr); hb[j * HB_LD + 64 + lane] = (bf16_t)f2bf(hi); }
            ssm_y_tile(U, dskip, Z, rowb + tl * 16, g, lane, Cop, hb);
        }
        if (wave == 7) { out[O_PRE + (size_t)(b * NG + g) * NST + lane] = hr; out[O_PIM + (size_t)(b * NG + g) * NST + lane] = hi; }
        __syncthreads();
    }
    const float* s0r = A->in[4]; const float* s0i = A->in[5];
    for (int task = blockIdx.x * 8 + wave; task < NG * (DB / 4); task += gridDim.x * 8) {
        const int g = task & 63, bq = task >> 6;
        bf16x8 Bop[8], Cop[4];
#pragma unroll
        for (int i = 0; i < 8; ++i) Bop[i] = *(const bf16x8*)(st + ST_BOP + ((size_t)(g * 8 + i) * 64 + lane) * 16);
#pragma unroll
        for (int i = 0; i < 4; ++i) Cop[i] = *(const bf16x8*)(st + ST_COP + ((size_t)(g * 4 + i) * 64 + lane) * 16);
        const float lr = ((const float*)(st + ST_LAM))[2 * (g * 64 + lane)], li = ((const float*)(st + ST_LAM))[2 * (g * 64 + lane) + 1];
        const int row0 = MP + bq * 16;
        ssm_bu_tile(U, row0, g, lane, Bop, bu);
        float hr = 0.f, hi = 0.f;
#pragma unroll
        for (int j = 0; j < 16; ++j) {
            const int bb = bq * 4 + (j >> 2);
            if ((j & 3) == 0) { hr = s0r[(size_t)(bb * NG + g) * NST + lane]; hi = s0i[(size_t)(bb * NG + g) * NST + lane]; }
            const float br = bu[j * BU_LD + lane], bi = bu[j * BU_LD + 64 + lane];
            const float nr = lr * hr - li * hi + br, ni = lr * hi + li * hr + bi; hr = nr; hi = ni;
            hb[j * HB_LD + lane] = (bf16_t)f2bf(hr); hb[j * HB_LD + 64 + lane] = (bf16_t)f2bf(hi);
            if ((j & 3) == 3) { out[O_SRE + (size_t)(bb * NG + g) * NST + lane] = hr; out[O_SIM + (size_t)(bb * NG + g) * NST + lane] = hi; }
        }
        ssm_y_tile(U, dskip, Z, row0, g, lane, Cop, hb);
    }
}

template <bool FINAL>
__device__ __forceinline__ void phase_ln(const float* X, const float* gam, const float* bet, float* O32, bf16_t* O16) {
    const int lane = lane_id(), wave = wave_id();
    const int gw = blockIdx.x * 8 + wave, NGW = gridDim.x * 8;
    for (int row = gw; row < MT; row += NGW) {
        const f32x4* xr = (const f32x4*)(X + (size_t)row * DM) + lane;
        f32x4 v[8]; float s = 0.f;
#pragma unroll
        for (int j = 0; j < 8; ++j) { v[j] = xr[64 * j]; s += (v[j][0] + v[j][1]) + (v[j][2] + v[j][3]); }
        const float mean = wave_sum(s) * (1.f / DM); float s2 = 0.f;
#pragma unroll
        for (int j = 0; j < 8; ++j) { v[j] = v[j] - mean; s2 += (v[j][0] * v[j][0] + v[j][1] * v[j][1]) + (v[j][2] * v[j][2] + v[j][3] * v[j][3]); }
        const float rstd = 1.f / sqrtf(wave_sum(s2) * (1.f / DM) + LN_EPS);
#pragma unroll
        for (int j = 0; j < 8; ++j) {
            const f32x4 gg = ((const f32x4*)gam)[lane + 64 * j], bb = ((const f32x4*)bet)[lane + 64 * j];
            const f32x4 o = v[j] * rstd * gg + bb;
            ((f32x4*)(O32 + (size_t)row * DM))[lane + 64 * j] = o;
            if (!FINAL) { u32x2 pk; pk.x = pk2(o[0], o[1]); pk.y = pk2(o[2], o[3]); ((u32x2*)(O16 + (size_t)row * DM))[lane + 64 * j] = pk; }
        }
    }
}

__device__ __forceinline__ void phase_softmax(const float* S, bf16_t* P) {
    const int lane = lane_id(), wave = wave_id();
    const int gw = blockIdx.x * 8 + wave, NGW = gridDim.x * 8;
    for (int row = gw; row < NB * NH * SEQ; row += NGW) {
        const f32x4 v = ((const f32x4*)(S + (size_t)row * NMEM))[lane];
        const float mx = wave_max(fmaxf(fmaxf(v[0], v[1]), fmaxf(v[2], v[3])));
        const float e0 = __expf(v[0] - mx), e1 = __expf(v[1] - mx), e2 = __expf(v[2] - mx), e3 = __expf(v[3] - mx);
        const float inv = 1.f / wave_sum((e0 + e1) + (e2 + e3));
        u32x2 pk; pk.x = pk2(e0 * inv, e1 * inv); pk.y = pk2(e2 * inv, e3 * inv);
        ((u32x2*)(P + (size_t)row * NMEM))[lane] = pk;
    }
}

__device__ __forceinline__ void phase_attn_sample(LAS unsigned char* lds) {
    const int lane = lane_id(), wave = wave_id();
    ArgP A = argp();
    const bf16_t* Q = (const bf16_t*)(A->ws + WS_Q); bf16_t* AO = (bf16_t*)(A->ws + WS_AO);
    const float* CK = A->in[7]; const float* CV = A->in[8];
    LAS float* sS = (LAS float*)lds;
    LAS float* sP = (LAS float*)(lds + 4096);
    LAS float* sR = (LAS float*)(lds + 8192);
    const int l16 = lane & 15, q = lane >> 4;
    for (int task = blockIdx.x; task < DB * NH; task += gridDim.x) {
        const int b = task >> 2, h = task & 3;
        f32x4 sacc[2] = {(f32x4){0.f, 0.f, 0.f, 0.f}, (f32x4){0.f, 0.f, 0.f, 0.f}};
        const bf16_t* qrow = Q + (size_t)(MP + b * 4 + (l16 & 3)) * DM + h * HD + 4 * q;
        const float* k0p = CK + ((size_t)(b * NMEM + wave * 32 + l16) * NH + h) * HD + 4 * q;
        const float* k1p = k0p + (size_t)16 * NH * HD;
#pragma unroll 4
        for (int ks = 0; ks < 16; ++ks) {
            u32x2 qa = *(const u32x2*)(qrow + 32 * ks), qb = *(const u32x2*)(qrow + 32 * ks + 16);
            if (l16 >= 4) { qa = (u32x2){0u, 0u}; qb = (u32x2){0u, 0u}; }
            const u32x4 aw = (u32x4){qa.x, qa.y, qb.x, qb.y};
            const f32x4 x0 = __builtin_nontemporal_load((const f32x4*)(k0p + 32 * ks)), x1 = __builtin_nontemporal_load((const f32x4*)(k0p + 32 * ks + 16));
            const f32x4 y0 = __builtin_nontemporal_load((const f32x4*)(k1p + 32 * ks)), y1 = __builtin_nontemporal_load((const f32x4*)(k1p + 32 * ks + 16));
            u32x4 bw0, bw1;
            bw0.x = pk2(x0[0], x0[1]); bw0.y = pk2(x0[2], x0[3]); bw0.z = pk2(x1[0], x1[1]); bw0.w = pk2(x1[2], x1[3]);
            bw1.x = pk2(y0[0], y0[1]); bw1.y = pk2(y0[2], y0[3]); bw1.z = pk2(y1[0], y1[1]); bw1.w = pk2(y1[2], y1[3]);
            sacc[0] = __builtin_amdgcn_mfma_f32_16x16x32_bf16(__builtin_bit_cast(bf16x8, aw), __builtin_bit_cast(bf16x8, bw0), sacc[0], 0, 0, 0);
            sacc[1] = __builtin_amdgcn_mfma_f32_16x16x32_bf16(__builtin_bit_cast(bf16x8, aw), __builtin_bit_cast(bf16x8, bw1), sacc[1], 0, 0, 0);
        }
        if (q == 0) {
#pragma unroll
            for (int t = 0; t < 4; ++t) { sS[t * 256 + wave * 32 + l16] = sacc[0][t]; sS[t * 256 + wave * 32 + 16 + l16] = sacc[1][t]; }
        }
        __syncthreads();
        if (wave < 4) {
            const f32x4 v = *(LAS f32x4*)(sS + wave * 256 + 4 * lane);
            const float mx = wave_max(fmaxf(fmaxf(v[0], v[1]), fmaxf(v[2], v[3])));
            const float e0 = __expf(v[0] - mx), e1 = __expf(v[1] - mx), e2 = __expf(v[2] - mx), e3 = __expf(v[3] - mx);
            const float inv = 1.f / wave_sum((e0 + e1) + (e2 + e3));
            sP[(4 * lane + 0) * 4 + wave] = e0 * inv; sP[(4 * lane + 1) * 4 + wave] = e1 * inv; sP[(4 * lane + 2) * 4 + wave] = e2 * inv; sP[(4 * lane + 3) * 4 + wave] = e3 * inv;
        }
        __syncthreads();
        f32x4 o0[4], o1[4];
#pragma unroll
        for (int t = 0; t < 4; ++t) { o0[t] = (f32x4){0.f, 0.f, 0.f, 0.f}; o1[t] = (f32x4){0.f, 0.f, 0.f, 0.f}; }
        const float* vp = CV + ((size_t)(b * NMEM + wave * 32) * NH + h) * HD + 4 * lane;
#pragma unroll 8
        for (int kx = 0; kx < 32; ++kx) {
            const f32x4 v0 = __builtin_nontemporal_load((const f32x4*)(vp + (size_t)kx * NH * HD)), v1 = __builtin_nontemporal_load((const f32x4*)(vp + (size_t)kx * NH * HD + 256));
            const f32x4 p = *(LAS f32x4*)(sP + (wave * 32 + kx) * 4);
#pragma unroll
            for (int t = 0; t < 4; ++t) { o0[t] += v0 * p[t]; o1[t] += v1 * p[t]; }
        }
#pragma unroll
        for (int t = 0; t < 4; ++t) { *(LAS f32x4*)(sR + (wave * 4 + t) * 512 + 4 * lane) = o0[t]; *(LAS f32x4*)(sR + (wave * 4 + t) * 512 + 256 + 4 * lane) = o1[t]; }
        __syncthreads();
        {
            const int t = threadIdx.x >> 7, d4 = (threadIdx.x & 127) * 4;
            f32x4 s = (f32x4){0.f, 0.f, 0.f, 0.f};
#pragma unroll
            for (int w2 = 0; w2 < 8; ++w2) s += *(LAS f32x4*)(sR + (w2 * 4 + t) * 512 + d4);
            u32x2 pk; pk.x = pk2(s[0], s[1]); pk.y = pk2(s[2], s[3]);
            *(u32x2*)(AO + (size_t)(MP + b * 4 + t) * DM + h * HD + d4) = pk;
        }
        __syncthreads();
    }
}

__device__ __forceinline__ void phase_act() {
    ArgP A = argp();
    const bf16_t* GU = (const bf16_t*)(A->ws + WS_GU); bf16_t* ACT = (bf16_t*)(A->ws + WS_ACT);
    const float* cw = A->in[33]; const float* cb = A->in[34]; const float* sc = A->in[6];
    const size_t gtid = (size_t)blockIdx.x * 512 + threadIdx.x, nthr = (size_t)gridDim.x * 512;
    constexpr int FG = DFF / 8;
    for (size_t it = gtid; it < (size_t)MT * FG; it += nthr) {
        const int fg = (int)(it % FG), row = (int)(it / FG), f0 = fg * 8;
        float g0[8], g1[8], g2[8], up[8];
        { const u32x4 w = *(const u32x4*)(GU + (size_t)row * (2 * DFF) + f0);
          g2[0] = bf2f(w.x & 0xffffu); g2[1] = bf2f(w.x >> 16); g2[2] = bf2f(w.y & 0xffffu); g2[3] = bf2f(w.y >> 16); g2[4] = bf2f(w.z & 0xffffu); g2[5] = bf2f(w.z >> 16); g2[6] = bf2f(w.w & 0xffffu); g2[7] = bf2f(w.w >> 16); }
        { const u32x4 w = *(const u32x4*)(GU + (size_t)row * (2 * DFF) + DFF + f0);
          up[0] = bf2f(w.x & 0xffffu); up[1] = bf2f(w.x >> 16); up[2] = bf2f(w.y & 0xffffu); up[3] = bf2f(w.y >> 16); up[4] = bf2f(w.z & 0xffffu); up[5] = bf2f(w.z >> 16); up[6] = bf2f(w.w & 0xffffu); up[7] = bf2f(w.w >> 16); }
        int t; const float* sb = nullptr;
        if (row < MP) t = row & (SEQ - 1); else { const int r = row - MP; t = r & 3; sb = sc + (size_t)(r >> 2) * 2 * DFF + f0; }
#pragma unroll
        for (int d = 1; d <= 2; ++d) {
            float* gd = (d == 1) ? g1 : g0;
            if (t - d >= 0) { const u32x4 w = *(const u32x4*)(GU + (size_t)(row - d) * (2 * DFF) + f0);
                gd[0] = bf2f(w.x & 0xffffu); gd[1] = bf2f(w.x >> 16); gd[2] = bf2f(w.y & 0xffffu); gd[3] = bf2f(w.y >> 16); gd[4] = bf2f(w.z & 0xffffu); gd[5] = bf2f(w.z >> 16); gd[6] = bf2f(w.w & 0xffffu); gd[7] = bf2f(w.w >> 16); }
            else if (sb) { const float* p = sb + (size_t)(2 + t - d) * DFF; const f32x4 a = *(const f32x4*)p, b = *(const f32x4*)(p + 4);
                gd[0] = a[0]; gd[1] = a[1]; gd[2] = a[2]; gd[3] = a[3]; gd[4] = b[0]; gd[5] = b[1]; gd[6] = b[2]; gd[7] = b[3]; }
            else {
#pragma unroll
                for (int e = 0; e < 8; ++e) gd[e] = 0.f; }
        }
        float o[8];
#pragma unroll
        for (int e = 0; e < 8; ++e) {
            const float gc = cb[f0 + e] + g0[e] * cw[f0 + e] + g1[e] * cw[DFF + f0 + e] + g2[e] * cw[2 * DFF + f0 + e];
            o[e] = gc / (1.f + __expf(-gc)) * up[e];
        }
        u32x4 w; w.x = pk2(o[0], o[1]); w.y = pk2(o[2], o[3]); w.z = pk2(o[4], o[5]); w.w = pk2(o[6], o[7]);
        *(u32x4*)(ACT + (size_t)row * DFF + f0) = w;
    }
}

constexpr int N_PHASES = 16;
__global__ void __launch_bounds__(512, 2) fwd_megakernel(Args args) {
    extern __shared__ __attribute__((aligned(16))) unsigned char lds_raw[];
    LAS unsigned char* lds = (LAS unsigned char*)lds_raw;
    const int G = gridDim.x, c0 = blockIdx.x;
    unsigned char* const ws = argp()->ws;
    const int lo = argp()->ph_lo, hi = argp()->ph_hi;
#define out (argp()->out)
    cg::grid_group grid = cg::this_grid();
    if (threadIdx.x < 4) ((LAS unsigned*)(lds + LDS_BYTES - 16))[threadIdx.x] = 0u;
    __syncthreads();
    XcdBarrier bar = xcd_barrier_post((unsigned*)ws, (volatile LAS unsigned*)(lds + LDS_BYTES - 16));
    if (hi > N_PHASES) grid.sync();
#define IN(k) (lo <= (k) && (k) < hi)
#define SEAM(k) do { if (IN(k) && IN((k) + 1)) xcd_barrier(bar); } while (0)
    using namespace pg8;
    const bf16_t* XB = (const bf16_t*)(ws + WS_XB);

    if (IN(0)) { phase_prep(lds); }
    SEAM(0);
    if (IN(1)) {
        {
            GridSched S{(const char*)XB, (const char*)(ws + WS_WIN), (long)256 * DM * 2, 0, (long)256 * DM * 2, MT / 256, DM / 256, (MT / 256) * (DM / 256), G, c0};
            EpiStore E{(float*)(ws + WS_U), nullptr, DM, 0, 0, 1.f, nullptr};
            gemm_phase(lds, Dims{DM, DM, DM}, S, E);
        }
        {
            GridSched S{(const char*)(ws + WS_MEMB), (const char*)(ws + WS_WKV), (long)256 * DM * 2, 0, (long)256 * DM * 2, 4, 16, 64, G, (c0 + G - 16) % G};
            EpiStore E{out + O_PMK, (bf16_t*)(ws + WS_KB), DM, DM, (size_t)NB * NMEM * DM, 1.f, nullptr};
            gemm_phase(lds, Dims{DM, DM, DM}, S, E);
        }
        {
            GridSched S{(const char*)(ws + WS_WKV) + (size_t)DM * DM * 2, (const char*)(ws + WS_MEMB), (long)256 * DM * 2, 0, (long)256 * DM * 2, 8, 4, 32, G, (c0 + G - 80) % G};
            EpiStore E{nullptr, (bf16_t*)(ws + WS_VT), NB * NMEM, 0, 0, 1.f, nullptr};
            gemm_phase(lds, Dims{DM, DM, DM}, S, E);
        }
    }
    SEAM(1);
    if (IN(2)) { phase_pool(); phase_ssm(lds); }
    SEAM(2);
    if (IN(3)) {
        {
            GridSched S{(const char*)(ws + WS_POOLED), (const char*)(ws + WS_WPOOL), (long)256 * DPOOL * 2, (long)256 * 2, (long)256 * 256 * 2, MT / 256, 4, (MT / 256) * 4, G, c0};
            EpiStore E{nullptr, (bf16_t*)(ws + WS_MIX), DM, 0, 0, 1.f, argp()->in[11]};
            gemm_phase(lds, Dims{DPOOL, 256, 256}, S, E);
        }
        {
            GridSched S{(const char*)(ws + WS_Z), (const char*)(ws + WS_WGLU), (long)256 * DSSM * 2, 0, (long)256 * DSSM * 2, MT / 256, 4, (MT / 256) * 4, G, (c0 + G - 136) % G};
            EpiGlu E{(const bf16_t*)(ws + WS_Z), argp()->in[21], (bf16_t*)(ws + WS_MIX)};
            gemm_phase(lds, Dims{DSSM, DSSM, DSSM}, S, E);
        }
    }
    SEAM(3);
    if (IN(4)) {
        GridSched S{(const char*)(ws + WS_MIX), (const char*)(ws + WS_WOUT), (long)256 * DM * 2, 0, (long)256 * DM * 2, MT / 256, DM / 256, (MT / 256) * (DM / 256), G, c0};
        EpiResid E{argp()->in[0], argp()->in[1], (float*)(ws + WS_PRE)};
        gemm_phase(lds, Dims{DM, DM, DM}, S, E);
    }
    SEAM(4);
    if (IN(5)) { phase_ln<false>((const float*)(ws + WS_PRE), argp()->in[23], argp()->in[24], (float*)(ws + WS_H1), (bf16_t*)(ws + WS_HB)); }
    SEAM(5);
    if (IN(6)) {
        GridSched S{(const char*)(ws + WS_HB), (const char*)(ws + WS_WQ), (long)256 * DM * 2, 0, (long)256 * DM * 2, MT / 256, DM / 256, (MT / 256) * (DM / 256), G, c0};
        EpiStore E{nullptr, (bf16_t*)(ws + WS_Q), DM, 0, 0, QSCALE, nullptr};
        gemm_phase(lds, Dims{DM, DM, DM}, S, E);
    }
    SEAM(6);
    if (IN(7)) {
        {
            SchedS S{(const char*)(ws + WS_Q), (const char*)(ws + WS_KB), G, c0};
            EpiStore E{(float*)(ws + WS_S), nullptr, NMEM, 0, 0, 1.f, nullptr};
            gemm_phase(lds, Dims{DM, DM, HD}, S, E);
        }
        phase_attn_sample(lds);
    }
    SEAM(7);
    if (IN(8)) { phase_softmax((const float*)(ws + WS_S), (bf16_t*)(ws + WS_P)); }
    SEAM(8);
    if (IN(9)) {
        SchedPV S{(const char*)(ws + WS_P), (const char*)(ws + WS_VT), G, c0};
        EpiStore E{nullptr, (bf16_t*)(ws + WS_AO), DM, 0, 0, 1.f, nullptr};
        gemm_phase(lds, Dims{NMEM, NB * NMEM, NMEM}, S, E);
    }
    SEAM(9);
    if (IN(10)) {
        GridSched S{(const char*)(ws + WS_AO), (const char*)(ws + WS_WO), (long)256 * DM * 2, 0, (long)256 * DM * 2, MT / 256, DM / 256, (MT / 256) * (DM / 256), G, c0};
        EpiResid E{(const float*)(ws + WS_H1), (const float*)(ws + WS_H1) + (size_t)MP * DM, (float*)(ws + WS_PRE)};
        gemm_phase(lds, Dims{DM, DM, DM}, S, E);
    }
    SEAM(10);
    if (IN(11)) { phase_ln<false>((const float*)(ws + WS_PRE), argp()->in[29], argp()->in[30], (float*)(ws + WS_H2), (bf16_t*)(ws + WS_HB)); }
    SEAM(11);
    if (IN(12)) {
        GridSched S{(const char*)(ws + WS_HB), (const char*)(ws + WS_WGU), (long)256 * DM * 2, 0, (long)256 * DM * 2, MT / 256, 2 * DFF / 256, (MT / 256) * (2 * DFF / 256), G, c0};
        EpiGateUp E{(bf16_t*)(ws + WS_GU), out + O_PCONV, out + O_SCONV};
        gemm_phase(lds, Dims{DM, DM, DM}, S, E);
    }
    SEAM(12);
    if (IN(13)) { phase_act(); }
    SEAM(13);
    if (IN(14)) {
        GridSched S{(const char*)(ws + WS_ACT), (const char*)(ws + WS_WDOWN), (long)256 * DFF * 2, 0, (long)256 * DFF * 2, MT / 256, DM / 256, (MT / 256) * (DM / 256), G, c0};
        EpiResid E{(const float*)(ws + WS_H2), (const float*)(ws + WS_H2) + (size_t)MP * DM, (float*)(ws + WS_PRE)};
        gemm_phase(lds, Dims{DFF, DFF, DFF}, S, E);
    }
    SEAM(14);
    if (IN(15)) { phase_ln<true>((const float*)(ws + WS_PRE), argp()->in[36], argp()->in[37], out + O_Y, nullptr); }
#undef IN
#undef SEAM
#undef out
}

extern "C" void kernel_launch(void* const* d_in, const int* in_sizes, int n_in, void* d_out, int out_size, void* d_ws, size_t ws_size, hipStream_t stream) {
    static int grid = 0;
    if (grid == 0) {
        if (n_in != 38 || (size_t)out_size != O_END || ws_size < WS_END) { fprintf(stderr, "kernel_launch: unexpected shapes: n_in %d out %d (want %zu) ws %zu (want %zu)\n", n_in, out_size, (size_t)O_END, ws_size, (size_t)WS_END); grid = -1; return; }
        int dev = 0, cus = 0, per_cu = 0;
        hipGetDevice(&dev);
        hipDeviceGetAttribute(&cus, hipDeviceAttributeMultiprocessorCount, dev);
        if (hipFuncSetAttribute((const void*)fwd_megakernel, hipFuncAttributeMaxDynamicSharedMemorySize, LDS_BYTES) != hipSuccess) { fprintf(stderr, "kernel_launch: hipFuncSetAttribute failed\n"); grid = -1; return; }
        if (hipOccupancyMaxActiveBlocksPerMultiprocessor(&per_cu, (const void*)fwd_megakernel, 512, LDS_BYTES) != hipSuccess || per_cu < 1) { fprintf(stderr, "kernel_launch: occupancy query says %d\n", per_cu); per_cu = 1; }
        (void)hipGetLastError();
        grid = cus * (per_cu > 1 ? 1 : per_cu);
        fprintf(stderr, "kernel_launch: grid %d (cus %d, per_cu %d)\n", grid, cus, per_cu);
    }
    if (grid < 0) return;
    Args a{};
    for (int i = 0; i < 38; ++i) a.in[i] = (const float*)d_in[i];
    a.out = (float*)d_out; a.ws = (unsigned char*)d_ws;
#if MK_PER_PHASE_LAUNCH
    for (int p = 0; p < N_PHASES; ++p) {
        a.ph_lo = p; a.ph_hi = p + 1;
        hipLaunchKernelGGL(fwd_megakernel, dim3(grid), dim3(512), LDS_BYTES, stream, a);
    }
#else
    a.ph_lo = 0; a.ph_hi = N_PHASES;
    if (hipMemsetAsync(d_ws, 0, 16384, stream) != hipSuccess) { fprintf(stderr, "kernel_launch: memset failed\n"); return; }
    void* kargs[] = {&a};
    hipError_t e = hipLaunchCooperativeKernel((const void*)fwd_megakernel, dim3(grid), dim3(512), kargs, LDS_BYTES, stream);
    if (e != hipSuccess) fprintf(stderr, "kernel_launch: cooperative launch failed: %s (grid %d)\n", hipGetErrorString(e), grid);
#endif
}
```

```cpp
#include <hip/hip_runtime.h>
#include <hip/hip_cooperative_groups.h>
#include <cstdio>
#include <cstdint>
namespace cg = cooperative_groups;

#ifndef MK_PER_PHASE_LAUNCH
#define MK_PER_PHASE_LAUNCH 0
#endif

#define LAS __attribute__((address_space(3)))
typedef unsigned short bf16_t;
typedef short bf16x8 __attribute__((ext_vector_type(8)));
typedef float f32x4 __attribute__((ext_vector_type(4)));
typedef float f32x2 __attribute__((ext_vector_type(2)));
typedef unsigned u32x4 __attribute__((ext_vector_type(4)));
typedef unsigned u32x2 __attribute__((ext_vector_type(2)));

constexpr int DM = 2048, NB = 4, SEQ = 2048, DB = 128, DT = 4;
constexpr int MP = NB * SEQ, MS = DB * DT, MT = MP + MS;
constexpr int DPOOL = 1024, DSSM = 1024, PBUF = 15, NG = 64, NST = 64, CH = 16;
constexpr int NMEM = 256, NH = 4, HD = 512, DFF = 5632;
constexpr float ALPHA = 1.189207115002721f;
constexpr float LN_EPS = 1e-5f;
constexpr float QSCALE = 0.04419417382415922f;

constexpr size_t O_Y = 0;
constexpr size_t O_PPOOL = (size_t)MT * DM;
constexpr size_t O_PRE = O_PPOOL + (size_t)NB * PBUF * DPOOL;
constexpr size_t O_PIM = O_PRE + (size_t)NB * NG * NST;
constexpr size_t O_PCONV = O_PIM + (size_t)NB * NG * NST;
constexpr size_t O_PMK = O_PCONV + (size_t)NB * 2 * DFF;
constexpr size_t O_PMV = O_PMK + (size_t)NB * NMEM * DM;
constexpr size_t O_SPOOL = O_PMV + (size_t)NB * NMEM * DM;
constexpr size_t O_SRE = O_SPOOL + (size_t)DB * PBUF * DPOOL;
constexpr size_t O_SIM = O_SRE + (size_t)DB * NG * NST;
constexpr size_t O_SCONV = O_SIM + (size_t)DB * NG * NST;
constexpr size_t O_END = O_SCONV + (size_t)DB * 2 * DFF;

constexpr size_t MiB = 1u << 20;
constexpr size_t WS_WIN = 1 * MiB;
constexpr size_t WS_WKV = WS_WIN + 8 * MiB;
constexpr size_t WS_WPOOL = WS_WKV + 16 * MiB;
constexpr size_t WS_WGLU = WS_WPOOL + 1 * MiB;
constexpr size_t WS_WOUT = WS_WGLU + 2 * MiB;
constexpr size_t WS_WQ = WS_WOUT + 8 * MiB;
constexpr size_t WS_WO = WS_WQ + 8 * MiB;
constexpr size_t WS_WGU = WS_WO + 8 * MiB;
constexpr size_t WS_WDOWN = WS_WGU + 44 * MiB;
constexpr size_t WS_SSMT = WS_WDOWN + 22 * MiB;
constexpr size_t WS_XB = WS_SSMT + 1 * MiB;
constexpr size_t WS_MEMB = WS_XB + 34 * MiB;
constexpr size_t WS_U = WS_MEMB + 4 * MiB;
constexpr size_t WS_POOLED = WS_U + 68 * MiB;
constexpr size_t WS_Z = WS_POOLED + 17 * MiB;
constexpr size_t WS_MIX = WS_Z + 17 * MiB;
constexpr size_t WS_PRE = WS_MIX + 34 * MiB;
constexpr size_t WS_H1 = WS_PRE + 68 * MiB;
constexpr size_t WS_H2 = WS_H1 + 68 * MiB;
constexpr size_t WS_HB = WS_H2 + 68 * MiB;
constexpr size_t WS_Q = WS_HB + 34 * MiB;
constexpr size_t WS_KB = WS_Q + 34 * MiB;
constexpr size_t WS_VT = WS_KB + 8 * MiB;
constexpr size_t WS_S = WS_VT + 4 * MiB;
constexpr size_t WS_P = WS_S + 32 * MiB;
constexpr size_t WS_AO = WS_P + 16 * MiB;
constexpr size_t WS_GU = WS_AO + 34 * MiB;
constexpr size_t WS_ACT = WS_GU + 187 * MiB;
constexpr size_t WS_END = WS_ACT + 94 * MiB;
constexpr size_t ST_BOP = 0;
constexpr size_t ST_COP = 512 * 1024;
constexpr size_t ST_LAM = 768 * 1024;

constexpr int LDS_BYTES = 147456;

__device__ __forceinline__ unsigned f2bf(float f) { unsigned u = __builtin_bit_cast(unsigned, f); return (u + 0x7fffu + ((u >> 16) & 1u)) >> 16; }
__device__ __forceinline__ unsigned pk2(float lo, float hi) { return f2bf(lo) | (f2bf(hi) << 16); }
__device__ __forceinline__ float bf2f(unsigned h) { return __builtin_bit_cast(float, h << 16); }
__device__ __forceinline__ float wave_sum(float v) {
#pragma unroll
    for (int o = 1; o < 64; o <<= 1) v += __shfl_xor(v, o);
    return v;
}
__device__ __forceinline__ float wave_max(float v) {
#pragma unroll
    for (int o = 1; o < 64; o <<= 1) v = fmaxf(v, __shfl_xor(v, o));
    return v;
}

__device__ __forceinline__ int lane_id() { int l = threadIdx.x & 63; asm volatile("" : "+v"(l)); return l; }
__device__ __forceinline__ int wave_id() { int t = threadIdx.x; asm volatile("" : "+v"(t)); return __builtin_amdgcn_readfirstlane(t >> 6); }

namespace pg8 {
constexpr int BM = 256, BK = 64, HALF = 128, HTB = HALF * BK * 2, STAGE_BYTES = 8 * HTB, NXCD = 8, WGM = 8;
__device__ __forceinline__ int lds_byte(int r, int c) { const int st = (r >> 4) * 2 + (c >> 5), rr = r & 15, cc = c & 31, ob = rr * 64 + cc * 2; return st * 1024 + (ob ^ (((ob >> 9) & 1) << 5)); }
__device__ __forceinline__ void stage_rc(int b, int& R, int& C) { const int st = b / 1024, sb = b % 1024, swz = sb ^ (((sb >> 9) & 1) << 5); R = (st >> 1) * 16 + swz / 64; C = (st & 1) * 32 + (swz % 64) / 2; }
__device__ __forceinline__ int perm32(int rho) { const int n = rho >> 4, i = rho & 15; return 8 * (i >> 2) + 4 * n + (i & 3); }

struct Unit { const char* a; const char* b; int row0, col0; };
struct Dims { int lda, ldb, K; };

struct GridSched {
    const char* A; const char* B; long a_pm, a_pn, b_pn; int nM, nN, nwg, G, c;
    __device__ __forceinline__ bool next(int i, Unit& u) const {
        const long L = (long)i * G + c; if (L >= nwg) return false;
        int wgid = (int)L; { const int q = nwg / NXCD, r = nwg % NXCD, xcd = wgid % NXCD, off = wgid / NXCD; wgid = (xcd < r ? xcd * (q + 1) : r * (q + 1) + (xcd - r) * q) + off; }
        const int nig = WGM * nN, gid = wgid / nig, fm = gid * WGM, gsz = (nM - fm) < WGM ? (nM - fm) : WGM;
        const int pm = fm + ((wgid % nig) % gsz), pn = (wgid % nig) / gsz;
        u.a = A + pm * a_pm + pn * a_pn; u.b = B + pn * b_pn; u.row0 = pm * BM; u.col0 = pn * BM; return true;
    }
};

template <class Epi, class Sched>
__device__ __forceinline__ void gemm_phase(LAS unsigned char* lds, const Dims g, const Sched& S, const Epi& E) {
    const int tid = threadIdx.x, wid = __builtin_amdgcn_readfirstlane(tid >> 6), lane = tid & 63, wr = wid >> 2, wc = wid & 3, fr = lane & 15, fq = lane >> 4;
    const int K = g.K, nt = K / BK;
    unsigned voffA[2], voffB[2];
#pragma unroll
    for (int i = 0; i < 2; ++i) { int R, C; stage_rc(tid * 16 + i * 8192, R, C); const int Rb = (R & ~31) + perm32(R & 31);
        voffA[i] = (unsigned)(R * g.lda + C) * 2u; voffB[i] = (unsigned)(Rb * g.ldb + C) * 2u; }
    const size_t kstep = (size_t)(BK * 2);
    const size_t hstepA = (size_t)HALF * g.lda * 2, hstepB = (size_t)HALF * g.ldb * 2;
    const unsigned ldsw = (unsigned)wid * 1024u;
    const int aoff = lds_byte(wr * 64 + fr, fq * 8), boff = lds_byte(wc * 32 + fr, fq * 8);
#define PG8_SA(b, h) (((b) * 2 + (h)) * HTB)
#define PG8_SB(b, h) ((4 + (b) * 2 + (h)) * HTB)
#define PG8_STAGE(bufoff, gbase, voff) do { _Pragma("unroll") for (int _i = 0; _i < 2; ++_i) \
        __builtin_amdgcn_global_load_lds((const unsigned*)((const char*)(gbase) + (voff)[_i]), (LAS unsigned*)(lds + (bufoff) + ldsw + _i * 8192), 16, 0, 0); } while (0)
#define PG8_LDA(dst, b, h) do { _Pragma("unroll") for (int m = 0; m < 4; ++m) _Pragma("unroll") for (int k = 0; k < 2; ++k) dst[m][k] = *(const LAS bf16x8*)(lds + PG8_SA(b, h) + aoff + m * 2048 + k * 1024); } while (0)
#define PG8_LDB(dst, b, h) do { _Pragma("unroll") for (int n = 0; n < 2; ++n) _Pragma("unroll") for (int k = 0; k < 2; ++k) dst[n][k] = *(const LAS bf16x8*)(lds + PG8_SB(b, h) + boff + n * 2048 + k * 1024); } while (0)
#define PG8_MMA(ai, bj, At, Bt) do { __builtin_amdgcn_s_setprio(1); _Pragma("unroll") for (int m = 0; m < 4; ++m) _Pragma("unroll") for (int n = 0; n < 2; ++n) _Pragma("unroll") for (int k = 0; k < 2; ++k) \
        acc[ai][bj][m][n] = __builtin_amdgcn_mfma_f32_16x16x32_bf16(Bt[n][k], At[m][k], acc[ai][bj][m][n], 0, 0, 0); __builtin_amdgcn_s_setprio(0); } while (0)
#define PG8_WAIT_V(n) asm volatile("s_waitcnt vmcnt(" #n ")" ::: "memory")
#define PG8_WAIT_L(n) asm volatile("s_waitcnt lgkmcnt(" #n ")" ::: "memory")
#define PG8_BAR __builtin_amdgcn_s_barrier()
#define PG8_SCHED __builtin_amdgcn_sched_barrier(0)
    Unit cur, nxt; int ui = 0;
    if (!S.next(0, cur)) return;
    f32x4 acc[2][2][4][2];
#pragma unroll
    for (int a = 0; a < 2; ++a)
#pragma unroll
        for (int b = 0; b < 2; ++b)
#pragma unroll
            for (int m = 0; m < 4; ++m)
#pragma unroll
                for (int n = 0; n < 2; ++n) acc[a][b][m][n] = (f32x4){0.f, 0.f, 0.f, 0.f};
    bf16x8 At[4][2], B0[2][2], B1[2][2];
    const char* cA = cur.a; const char* cB = cur.b;
    PG8_STAGE(PG8_SB(0, 0), cB, voffB); PG8_STAGE(PG8_SB(0, 1), cB + hstepB, voffB); PG8_STAGE(PG8_SA(0, 0), cA, voffA); PG8_STAGE(PG8_SA(0, 1), cA + hstepA, voffA);
    if (wr == 1) PG8_BAR;
    PG8_WAIT_V(2); PG8_BAR;
    PG8_STAGE(PG8_SB(1, 0), cB + kstep, voffB); PG8_STAGE(PG8_SA(1, 0), cA + kstep, voffA); PG8_STAGE(PG8_SB(1, 1), cB + hstepB + kstep, voffB);
    PG8_WAIT_V(6); PG8_BAR;
    for (;;) {
        const bool has_next = S.next(ui + 1, nxt);
        const char* nA = has_next ? nxt.a : cA; const char* nB = has_next ? nxt.b : cB;
        for (int t = 0; t < nt; t += 2) {
            const bool last = (t == nt - 2);
            const char* a1 = cA + (size_t)(t + 1) * kstep;
            const char* a2 = last ? nA : cA + (size_t)(t + 2) * kstep; const char* b2 = last ? nB : cB + (size_t)(t + 2) * kstep;
            const char* a3 = a2 + kstep; const char* b3 = b2 + kstep;
            PG8_LDB(B0, 0, 0); PG8_LDB(B1, 0, 1); PG8_SCHED; PG8_LDA(At, 0, 0); PG8_STAGE(PG8_SA(1, 1), a1 + hstepA, voffA);
            PG8_WAIT_V(8); PG8_WAIT_L(0); PG8_BAR; PG8_MMA(0, 0, At, B0); PG8_MMA(0, 1, At, B1); PG8_BAR; PG8_SCHED;
            PG8_LDA(At, 0, 1); PG8_STAGE(PG8_SB(0, 0), b2, voffB); PG8_STAGE(PG8_SB(0, 1), b2 + hstepB, voffB); PG8_STAGE(PG8_SA(0, 0), a2, voffA);
            PG8_WAIT_V(8); PG8_WAIT_L(0); PG8_BAR; PG8_MMA(1, 0, At, B0); PG8_MMA(1, 1, At, B1); PG8_BAR; PG8_SCHED;
            PG8_LDB(B0, 1, 0); PG8_LDB(B1, 1, 1); PG8_SCHED; PG8_LDA(At, 1, 0); PG8_STAGE(PG8_SA(0, 1), a2 + hstepA, voffA);
            PG8_WAIT_V(8); PG8_WAIT_L(0); PG8_BAR; PG8_MMA(0, 0, At, B0); PG8_MMA(0, 1, At, B1); PG8_BAR; PG8_SCHED;
            PG8_LDA(At, 1, 1); PG8_STAGE(PG8_SB(1, 0), b3, voffB); PG8_STAGE(PG8_SB(1, 1), b3 + hstepB, voffB); PG8_STAGE(PG8_SA(1, 0), a3, voffA);
            PG8_WAIT_V(8); PG8_WAIT_L(0); PG8_BAR; PG8_MMA(1, 0, At, B0); PG8_MMA(1, 1, At, B1); PG8_BAR; PG8_SCHED;
        }
        if (wr == 0) PG8_BAR;
        E(acc, cur, wr, wc, fr, fq);
        if (!has_next) break;
#pragma unroll
        for (int a = 0; a < 2; ++a)
#pragma unroll
            for (int b = 0; b < 2; ++b)
#pragma unroll
                for (int m = 0; m < 4; ++m)
#pragma unroll
                    for (int n = 0; n < 2; ++n) acc[a][b][m][n] = (f32x4){0.f, 0.f, 0.f, 0.f};
        cur = nxt; cA = nA; cB = nB; ++ui;
        if (wr == 1) PG8_BAR;
    }
    PG8_WAIT_V(0);
    PG8_BAR;
#undef PG8_SA
#undef PG8_SB
#undef PG8_STAGE
#undef PG8_LDA
#undef PG8_LDB
#undef PG8_MMA
#undef PG8_WAIT_V
#undef PG8_WAIT_L
#undef PG8_BAR
#undef PG8_SCHED
}

typedef const f32x4 (&AccRef)[2][2][4][2];

struct EpiStore {
    float* F; bf16_t* Bo; int ld; int split_cols; size_t split_stride; float scale; const float* colscale;
    __device__ __forceinline__ void operator()(AccRef acc, const Unit& u, int wr, int wc, int fr, int fq) const {
        int colt = u.col0; size_t soff = 0;
        if (split_cols) { const int t = colt / split_cols; soff = (size_t)t * split_stride; colt -= t * split_cols; }
        const int col0 = colt + wc * 32 + 8 * fq, row0 = u.row0 + wr * 64 + fr;
        f32x4 cs[2][2];
#pragma unroll
        for (int bj = 0; bj < 2; ++bj)
#pragma unroll
            for (int n = 0; n < 2; ++n) { cs[bj][n] = colscale ? *(const f32x4*)(colscale + col0 + bj * HALF + 4 * n) : (f32x4){1.f, 1.f, 1.f, 1.f}; cs[bj][n] = cs[bj][n] * scale; }
#pragma unroll
        for (int ai = 0; ai < 2; ++ai)
#pragma unroll
            for (int m = 0; m < 4; ++m) {
                const size_t off = soff + (size_t)(row0 + ai * HALF + m * 16) * ld + col0;
#pragma unroll
                for (int bj = 0; bj < 2; ++bj) {
                    const f32x4 v0 = acc[ai][bj][m][0] * cs[bj][0], v1 = acc[ai][bj][m][1] * cs[bj][1];
                    if (F) { *(f32x4*)(F + off + bj * HALF) = v0; *(f32x4*)(F + off + bj * HALF + 4) = v1; }
                    if (Bo) { u32x4 w; w.x = pk2(v0[0], v0[1]); w.y = pk2(v0[2], v0[3]); w.z = pk2(v1[0], v1[1]); w.w = pk2(v1[2], v1[3]); *(u32x4*)(Bo + off + bj * HALF) = w; }
                }
            }
    }
};

struct EpiGlu {
    const bf16_t* Z; const float* bias; bf16_t* O;
    __device__ __forceinline__ void operator()(AccRef acc, const Unit& u, int wr, int wc, int fr, int fq) const {
        const int col0 = u.col0 + wc * 32 + 8 * fq, row0 = u.row0 + wr * 64 + fr;
        f32x4 bv[2][2];
#pragma unroll
        for (int bj = 0; bj < 2; ++bj)
#pragma unroll
            for (int n = 0; n < 2; ++n) bv[bj][n] = *(const f32x4*)(bias + col0 + bj * HALF + 4 * n);
#pragma unroll
        for (int ai = 0; ai < 2; ++ai)
#pragma unroll
            for (int m = 0; m < 4; ++m) {
                const size_t row = (size_t)(row0 + ai * HALF + m * 16);
#pragma unroll
                for (int bj = 0; bj < 2; ++bj) {
                    const u32x4 zz = *(const u32x4*)(Z + row * DSSM + col0 + bj * HALF);
                    const f32x4 a0 = acc[ai][bj][m][0] + bv[bj][0], a1 = acc[ai][bj][m][1] + bv[bj][1];
                    float o[8];
#pragma unroll
                    for (int e = 0; e < 8; ++e) {
                        const unsigned zw = (e < 2) ? zz.x : (e < 4) ? zz.y : (e < 6) ? zz.z : zz.w;
                        const float zf = (e & 1) ? bf2f(zw >> 16) : bf2f(zw & 0xffffu);
                        const float av = (e < 4) ? a0[e & 3] : a1[e & 3];
                        o[e] = zf / (1.f + __expf(-av));
                    }
                    u32x4 w; w.x = pk2(o[0], o[1]); w.y = pk2(o[2], o[3]); w.z = pk2(o[4], o[5]); w.w = pk2(o[6], o[7]);
                    *(u32x4*)(O + row * DM + DPOOL + col0 + bj * HALF) = w;
                }
            }
    }
};

struct EpiResid {
    const float* res0; const float* res1; float* O;
    __device__ __forceinline__ void operator()(AccRef acc, const Unit& u, int wr, int wc, int fr, int fq) const {
        const int col0 = u.col0 + wc * 32 + 8 * fq, row0 = u.row0 + wr * 64 + fr;
        const float* rb = (u.row0 < MP) ? res0 : (res1 - (size_t)MP * DM);
#pragma unroll
        for (int ai = 0; ai < 2; ++ai)
#pragma unroll
            for (int m = 0; m < 4; ++m) {
                const size_t off = (size_t)(row0 + ai * HALF + m * 16) * DM + col0;
#pragma unroll
                for (int bj = 0; bj < 2; ++bj) {
                    const f32x4 r0 = *(const f32x4*)(rb + off + bj * HALF), r1 = *(const f32x4*)(rb + off + bj * HALF + 4);
                    *(f32x4*)(O + off + bj * HALF) = r0 * ALPHA + acc[ai][bj][m][0];
                    *(f32x4*)(O + off + bj * HALF + 4) = r1 * ALPHA + acc[ai][bj][m][1];
                }
                if (m & 1) asm volatile("" ::: "memory");
            }
    }
};

struct EpiGateUp {
    bf16_t* O; float* pconv; float* sconv;
    __device__ __forceinline__ void operator()(AccRef acc, const Unit& u, int wr, int wc, int fr, int fq) const {
        const int col0 = u.col0 + wc * 32 + 8 * fq, row0 = u.row0 + wr * 64 + fr;
        const bool gate = u.col0 < DFF;
#pragma unroll
        for (int ai = 0; ai < 2; ++ai)
#pragma unroll
            for (int m = 0; m < 4; ++m) {
                const int row = row0 + ai * HALF + m * 16;
                const size_t off = (size_t)row * (2 * DFF) + col0;
                float* st = nullptr;
                if (gate) {
                    if (row < MP) { const int t = row & (SEQ - 1); if (t >= SEQ - 2) st = pconv + ((size_t)(row >> 11) * 2 + (t - (SEQ - 2))) * DFF; }
                    else { const int r = row - MP, t = r & 3; if (t >= 2) st = sconv + ((size_t)(r >> 2) * 2 + (t - 2)) * DFF; }
                }
#pragma unroll
                for (int bj = 0; bj < 2; ++bj) {
                    const f32x4 v0 = acc[ai][bj][m][0], v1 = acc[ai][bj][m][1];
                    u32x4 w; w.x = pk2(v0[0], v0[1]); w.y = pk2(v0[2], v0[3]); w.z = pk2(v1[0], v1[1]); w.w = pk2(v1[2], v1[3]);
                    *(u32x4*)(O + off + bj * HALF) = w;
                    if (st) { *(f32x4*)(st + col0 + bj * HALF) = v0; *(f32x4*)(st + col0 + bj * HALF + 4) = v1; }
                }
            }
    }
};

struct SchedS {
    const char* Q; const char* Kb; int G, c;
    __device__ __forceinline__ bool next(int i, Unit& u) const {
        const int L = i * G + c; if (L >= 128) return false;
        const int z = L >> 3, pm = L & 7, b = z >> 2, h = z & 3;
        u.a = Q + ((size_t)(b * SEQ + pm * 256) * DM + h * HD) * 2; u.b = Kb + ((size_t)(b * NMEM) * DM + h * HD) * 2;
        u.row0 = z * SEQ + pm * 256; u.col0 = 0; return true;
    }
};
struct SchedPV {
    const char* P; const char* Vt; int G, c;
    __device__ __forceinline__ bool next(int i, Unit& u) const {
        const int L = i * G + c; if (L >= 256) return false;
        const int pn = L & 1, pm = (L >> 1) & 7, z = L >> 4, b = z >> 2, h = z & 3;
        u.a = P + ((size_t)(z * SEQ + pm * 256) * NMEM) * 2; u.b = Vt + ((size_t)(h * HD + pn * 256) * (NB * NMEM) + b * NMEM) * 2;
        u.row0 = b * SEQ + pm * 256; u.col0 = h * HD + pn * 256; return true;
    }
};
}

#define XB_TMO      128
#define XB_XCNT(j)  (256  + 64 * (j))
#define XB_XSUB(j)  (1280 + 64 * (j))
#define XB_XGEN(j)  (2304 + 64 * (j))
#define XB_TOP      3328
#define XB_TOPGEN   3392
#define XCD_BAR_WORDS 3456
#define XB_SPIN_CAP (1u << 18)

__device__ __forceinline__ unsigned xb_ld(unsigned* p)              { return __hip_atomic_load(p, __ATOMIC_RELAXED, __HIP_MEMORY_SCOPE_AGENT); }
__device__ __forceinline__ unsigned xb_add(unsigned* p, unsigned v) { return __hip_atomic_fetch_add(p, v, __ATOMIC_RELAXED, __HIP_MEMORY_SCOPE_AGENT); }
__device__ __forceinline__ unsigned xb_xcc_id() { return (unsigned)__builtin_amdgcn_s_getreg((3 << 11) | 20) & 0xFu; }
#define XB_SPIN(cond, bar) do { unsigned _sp = 0; while (cond) { __builtin_amdgcn_s_sleep(1); \
    if ((++_sp & 255u) == 0u) { if (xb_ld(&(bar)[XB_TMO])) break; if (_sp > XB_SPIN_CAP) { atomicAdd(&(bar)[XB_TMO], 1u); break; } } } } while (0)

struct XcdBarrier {
    unsigned* bar; unsigned x;
    volatile LAS unsigned* st;
};

__device__ __forceinline__ XcdBarrier xcd_barrier_post(unsigned* bar, volatile LAS unsigned* st) {
    XcdBarrier b; b.bar = bar; b.x = xb_xcc_id(); b.st = st;
    if (threadIdx.x == 0) (void)xb_add(&bar[XB_XCNT(b.x)], 1u);
    return b;
}
__device__ __forceinline__ void xcd_barrier_complete(unsigned* bar, unsigned x, unsigned& nloc, unsigned& nx) {
    const unsigned G = gridDim.x * gridDim.y * gridDim.z;
    unsigned sum, cnt, mine, sp = 0u;
    for (;;) {
        sum = 0u; cnt = 0u; mine = 0u;
#pragma unroll
        for (unsigned j = 0; j < 16; ++j) { const unsigned c = xb_ld(&bar[XB_XCNT(j)]); sum += c; cnt += (c > 0u) ? 1u : 0u; mine = (j == x) ? c : mine; }
        if (sum == G) break;
        __builtin_amdgcn_s_sleep(1);
        if ((++sp & 255u) == 0u) { if (xb_ld(&bar[XB_TMO])) break; if (sp > XB_SPIN_CAP) { atomicAdd(&bar[XB_TMO], 1u); break; } }
    }
    nloc = mine > 0u ? mine : 1u; nx = cnt > 0u ? cnt : 1u;
}

__device__ __forceinline__ void xcd_barrier(const XcdBarrier& b) {
    asm volatile("s_waitcnt vmcnt(0)" ::: "memory");
    __syncthreads();
    if (threadIdx.x == 0) {
        unsigned* bar = b.bar;
        __builtin_amdgcn_s_waitcnt(0);
        unsigned nloc = b.st[0], nx = b.st[1];
        if (nloc == 0u) { xcd_barrier_complete(bar, b.x, nloc, nx); b.st[0] = nloc; b.st[1] = nx; }
        const unsigned old = xb_add(&bar[XB_XSUB(b.x)], 1u);
        const unsigned gen = old / nloc;
        if (old + 1u == (gen + 1u) * nloc) {
            __builtin_amdgcn_fence(__ATOMIC_RELEASE, "agent");
            asm volatile("s_waitcnt vmcnt(0)" ::: "memory");
            const unsigned og = xb_add(&bar[XB_TOP], 1u);
            const unsigned tg = og / nx;
            if (og + 1u == (tg + 1u) * nx) xb_add(&bar[XB_TOPGEN], 1u);
            else XB_SPIN(xb_ld(&bar[XB_TOPGEN]) == tg, bar);
            __builtin_amdgcn_fence(__ATOMIC_ACQUIRE, "agent");
            xb_add(&bar[XB_XGEN(b.x)], 1u);
            asm volatile("s_waitcnt vmcnt(0)" ::: "memory");
        } else {
            XB_SPIN(xb_ld(&bar[XB_XGEN(b.x)]) == gen, bar);
            __builtin_amdgcn_fence(__ATOMIC_ACQUIRE, "agent");
            asm volatile("s_waitcnt vmcnt(0)" ::: "memory");
        }
    }
    __syncthreads();
}


constexpr int SK_LD = 68;
template <class Epi>
__device__ __forceinline__ void skinny_gemm(LAS unsigned char* lds, const bf16_t* A, int lda, const bf16_t* Bt, int ldb, int K, const Epi& E) {
    const int tid = threadIdx.x, lane = lane_id(), wave = wave_id(), l16 = lane & 15, q = lane >> 4;
    LAS float* red = (LAS float*)lds;
    const int ks = K / 8;
    for (int p = blockIdx.x; p < 256; p += gridDim.x) {
        const int rb = p & 7, cb = p >> 3;
        f32x4 acc[4][4];
#pragma unroll
        for (int i = 0; i < 4; ++i)
#pragma unroll
            for (int j = 0; j < 4; ++j) acc[i][j] = (f32x4){0.f, 0.f, 0.f, 0.f};
        const bf16_t* ap = A + (size_t)(rb * 64 + l16) * lda + wave * ks + 8 * q;
        const bf16_t* bp = Bt + (size_t)(cb * 64 + l16) * ldb + wave * ks + 8 * q;
#pragma unroll 2
        for (int k = 0; k < ks; k += 32) {
            bf16x8 af[4], bfr[4];
#pragma unroll
            for (int i = 0; i < 4; ++i) af[i] = *(const bf16x8*)(ap + (size_t)(16 * i) * lda + k);
#pragma unroll
            for (int j = 0; j < 4; ++j) bfr[j] = *(const bf16x8*)(bp + (size_t)(16 * j) * ldb + k);
#pragma unroll
            for (int i = 0; i < 4; ++i)
#pragma unroll
                for (int j = 0; j < 4; ++j) acc[i][j] = __builtin_amdgcn_mfma_f32_16x16x32_bf16(bfr[j], af[i], acc[i][j], 0, 0, 0);
        }
#pragma unroll
        for (int i = 0; i < 4; ++i)
#pragma unroll
            for (int j = 0; j < 4; ++j) *(LAS f32x4*)(red + (wave * 64 + 16 * i + l16) * SK_LD + 16 * j + 4 * q) = acc[i][j];
        __syncthreads();
        {
            const int r = tid >> 3, c8 = (tid & 7) * 8;
            f32x4 s0 = (f32x4){0.f, 0.f, 0.f, 0.f}, s1 = (f32x4){0.f, 0.f, 0.f, 0.f};
#pragma unroll
            for (int w = 0; w < 8; ++w) { s0 += *(LAS f32x4*)(red + (w * 64 + r) * SK_LD + c8); s1 += *(LAS f32x4*)(red + (w * 64 + r) * SK_LD + c8 + 4); }
            E(s0, s1, rb * 64 + r, cb * 64 + c8);
        }
        __syncthreads();
    }
}
struct SkStore {
    float* F; bf16_t* Bo; float scale;
    __device__ __forceinline__ void operator()(f32x4 v0, f32x4 v1, int row, int col) const {
        v0 = v0 * scale; v1 = v1 * scale;
        if (F) { *(f32x4*)(F + (size_t)row * DM + col) = v0; *(f32x4*)(F + (size_t)row * DM + col + 4) = v1; }
        if (Bo) { u32x4 w; w.x = pk2(v0[0], v0[1]); w.y = pk2(v0[2], v0[3]); w.z = pk2(v1[0], v1[1]); w.w = pk2(v1[2], v1[3]); *(u32x4*)(Bo + (size_t)row * DM + col) = w; }
    }
};
struct SkResid {
    const float* res; float* O;
    __device__ __forceinline__ void operator()(f32x4 v0, f32x4 v1, int row, int col) const {
        const size_t off = (size_t)row * DM + col;
        const f32x4 r0 = *(const f32x4*)(res + off), r1 = *(const f32x4*)(res + off + 4);
        *(f32x4*)(O + off) = r0 * ALPHA + v0; *(f32x4*)(O + off + 4) = r1 * ALPHA + v1;
    }
};

struct Args { const float* in[38]; float* out; unsigned char* ws; int ph_lo, ph_hi; };
#define CAS __attribute__((address_space(4)))
typedef const CAS Args* ArgP;
__device__ __forceinline__ ArgP argp() { ArgP p = (ArgP)__builtin_amdgcn_kernarg_segment_ptr(); asm volatile("" : "+s"(p)); return p; }

__device__ __forceinline__ void transpose_item(const float* W, int K, int N, bf16_t* WT, int row_off, LAS float* scr, int item, int lane) {
    const int nblk = N / 32, kb = item / nblk, nb = item % nblk, k0 = 64 * kb, n0 = 32 * nb;
#pragma unroll 8
    for (int i = 0; i < 32; ++i) { const int kk = 2 * i + (lane >> 5); scr[kk * 33 + (lane & 31)] = W[(size_t)(k0 + kk) * N + n0 + (lane & 31)]; }
    asm volatile("s_waitcnt lgkmcnt(0)" ::: "memory");
    const int c = lane & 7;
#pragma unroll
    for (int j = 0; j < 4; ++j) { const int n = (lane >> 3) + 8 * j; const LAS float* s = scr + (8 * c) * 33 + n;
        u32x4 o; o.x = pk2(s[0 * 33], s[1 * 33]); o.y = pk2(s[2 * 33], s[3 * 33]); o.z = pk2(s[4 * 33], s[5 * 33]); o.w = pk2(s[6 * 33], s[7 * 33]);
        *(u32x4*)(WT + (size_t)(row_off + n0 + n) * K + k0 + 8 * c) = o; }
    asm volatile("s_waitcnt lgkmcnt(0)" ::: "memory");
}

__device__ __forceinline__ void cvt_rows(const float* src, bf16_t* dst, size_t n8, size_t gtid, size_t nthr) {
    for (size_t i = gtid; i < n8; i += nthr) {
        const f32x4 a = *(const f32x4*)(src + i * 8), b = *(const f32x4*)(src + i * 8 + 4);
        u32x4 w; w.x = pk2(a[0], a[1]); w.y = pk2(a[2], a[3]); w.z = pk2(b[0], b[1]); w.w = pk2(b[2], b[3]);
        *(u32x4*)(dst + i * 8) = w;
    }
}

__device__ __forceinline__ void phase_prep(LAS unsigned char* lds) {
    const int lane = lane_id(), wave = wave_id();
    ArgP A = argp(); unsigned char* ws = A->ws;
    const int G = gridDim.x, gw = blockIdx.x * 8 + wave, NGW = G * 8;
    LAS float* scr = (LAS float*)(lds + wave * 16384);
    constexpr int I_SQ = 2048, I_POOL = 32, I_GLU = 512, I_FF = 5632;
    constexpr int NITEMS = 3 * I_FF + 6 * I_SQ + I_GLU + 4 * I_POOL;
    for (int it = gw; it < NITEMS; it += NGW) {
        int r = it;
        if (r < I_FF) { transpose_item(A->in[31], DM, DFF, (bf16_t*)(ws + WS_WGU), 0, scr, r, lane); continue; } r -= I_FF;
        if (r < I_FF) { transpose_item(A->in[32], DM, DFF, (bf16_t*)(ws + WS_WGU), DFF, scr, r, lane); continue; } r -= I_FF;
        if (r < I_FF) { transpose_item(A->in[35], DFF, DM, (bf16_t*)(ws + WS_WDOWN), 0, scr, r, lane); continue; } r -= I_FF;
        if (r < I_SQ) { transpose_item(A->in[9], DM, DM, (bf16_t*)(ws + WS_WIN), 0, scr, r, lane); continue; } r -= I_SQ;
        if (r < I_SQ) { transpose_item(A->in[26], DM, DM, (bf16_t*)(ws + WS_WKV), 0, scr, r, lane); continue; } r -= I_SQ;
        if (r < I_SQ) { transpose_item(A->in[27], DM, DM, (bf16_t*)(ws + WS_WKV), DM, scr, r, lane); continue; } r -= I_SQ;
        if (r < I_SQ) { transpose_item(A->in[22], DM, DM, (bf16_t*)(ws + WS_WOUT), 0, scr, r, lane); continue; } r -= I_SQ;
        if (r < I_SQ) { transpose_item(A->in[25], DM, DM, (bf16_t*)(ws + WS_WQ), 0, scr, r, lane); continue; } r -= I_SQ;
        if (r < I_SQ) { transpose_item(A->in[28], DM, DM, (bf16_t*)(ws + WS_WO), 0, scr, r, lane); continue; } r -= I_SQ;
        if (r < I_GLU) { transpose_item(A->in[20], DSSM, DSSM, (bf16_t*)(ws + WS_WGLU), 0, scr, r, lane); continue; } r -= I_GLU;
        { const int g = r / I_POOL; transpose_item(A->in[10] + (size_t)g * 65536, 256, 256, (bf16_t*)(ws + WS_WPOOL) + (size_t)g * 65536, 0, scr, r % I_POOL, lane); }
    }
    const size_t gtid = (size_t)blockIdx.x * 512 + threadIdx.x, nthr = (size_t)G * 512;
    cvt_rows(A->in[0], (bf16_t*)(ws + WS_XB), (size_t)MP * DM / 8, gtid, nthr);
    cvt_rows(A->in[1], (bf16_t*)(ws + WS_XB) + (size_t)MP * DM, (size_t)MS * DM / 8, gtid, nthr);
    cvt_rows(A->in[2], (bf16_t*)(ws + WS_MEMB), (size_t)NB * NMEM * DM / 8, gtid, nthr);
    const float* lre = A->in[12]; const float* lim = A->in[13]; const float* lstep = A->in[14];
    const float* bre = A->in[15]; const float* bim = A->in[16]; const float* cre = A->in[17]; const float* cim = A->in[18];
    unsigned char* st = ws + WS_SSMT;
    for (size_t i = gtid; i < (size_t)NG * NST; i += nthr) {
        const int g = (int)(i >> 6), n = (int)(i & 63);
        const float dt = expf(lstep[g]);
        const float ar = lre[i], ai = lim[i];
        const float er = expf(ar * dt); float sn, cs; sincosf(ai * dt, &sn, &cs);
        const float br = er * cs, bi = er * sn;
        ((float*)(st + ST_LAM))[2 * i] = br; ((float*)(st + ST_LAM))[2 * i + 1] = bi;
        const float nr = br - 1.f, ni = bi, den = ar * ar + ai * ai;
        const float fr_ = (nr * ar + ni * ai) / den, fi_ = (ni * ar - nr * ai) / den;
        float pr[16], pi[16];
#pragma unroll
        for (int c = 0; c < 16; ++c) { const float x = bre[i * 16 + c], y = bim[i * 16 + c]; pr[c] = fr_ * x - fi_ * y; pi[c] = fr_ * y + fi_ * x; }
        u32x4* bop = (u32x4*)(st + ST_BOP) + (size_t)g * 8 * 64;
        const int blk = n >> 4, l16 = n & 15;
        u32x4 w;
        w.x = pk2(pr[0], pr[1]); w.y = pk2(pr[2], pr[3]); w.z = pk2(pr[4], pr[5]); w.w = pk2(pr[6], pr[7]); bop[(blk) * 64 + 0 * 16 + l16] = w;
        w.x = pk2(pr[8], pr[9]); w.y = pk2(pr[10], pr[11]); w.z = pk2(pr[12], pr[13]); w.w = pk2(pr[14], pr[15]); bop[(blk) * 64 + 1 * 16 + l16] = w;
        w.x = pk2(pi[0], pi[1]); w.y = pk2(pi[2], pi[3]); w.z = pk2(pi[4], pi[5]); w.w = pk2(pi[6], pi[7]); bop[(4 + blk) * 64 + 0 * 16 + l16] = w;
        w.x = pk2(pi[8], pi[9]); w.y = pk2(pi[10], pi[11]); w.z = pk2(pi[12], pi[13]); w.w = pk2(pi[14], pi[15]); bop[(4 + blk) * 64 + 1 * 16 + l16] = w;
        const u32x4 zz = (u32x4){0u, 0u, 0u, 0u};
        bop[(blk) * 64 + 2 * 16 + l16] = zz; bop[(blk) * 64 + 3 * 16 + l16] = zz; bop[(4 + blk) * 64 + 2 * 16 + l16] = zz; bop[(4 + blk) * 64 + 3 * 16 + l16] = zz;
    }
    for (size_t i = gtid; i < (size_t)NG * 4 * 64; i += nthr) {
        const int L = (int)(i & 63), kk = (int)((i >> 6) & 3), g = (int)(i >> 8);
        const int c = L & 15, q = L >> 4, k0 = 32 * kk + 8 * q;
        float v[8];
#pragma unroll
        for (int e = 0; e < 8; ++e) { const int k = k0 + e; v[e] = (k < 64) ? cre[((size_t)g * 16 + c) * 64 + k] : -cim[((size_t)g * 16 + c) * 64 + (k - 64)]; }
        u32x4 w; w.x = pk2(v[0], v[1]); w.y = pk2(v[2], v[3]); w.z = pk2(v[4], v[5]); w.w = pk2(v[6], v[7]);
        ((u32x4*)(st + ST_COP))[i] = w;
    }
}

__device__ __forceinline__ void phase_pool() {
    ArgP A = argp(); unsigned char* ws = A->ws; const float* U = (const float*)(ws + WS_U); bf16_t* PO = (bf16_t*)(ws + WS_POOLED);
    const size_t gtid = (size_t)blockIdx.x * 512 + threadIdx.x, nthr = (size_t)gridDim.x * 512;
    for (size_t it = gtid; it < (size_t)(MP / 16) * 256; it += nthr) {
        const int qd = (int)(it & 255), tb = (int)(it >> 8), ch = qd * 4, w = 2 << (ch >> 8);
        const int row0 = tb * 16, t0 = row0 & (SEQ - 1);
        const float* up = U + (size_t)row0 * DM + ch;
        f32x4 s = (f32x4){0.f, 0.f, 0.f, 0.f};
        for (int j = 1; j < w; ++j) if (t0 - j >= 0) s += *(const f32x4*)(up - (size_t)j * DM);
        for (int j = 0; j < 16; ++j) {
            const f32x4 x = *(const f32x4*)(up + (size_t)j * DM);
            s += x;
            const int t = t0 + j; const float inv = 1.f / (float)((t + 1 < w) ? (t + 1) : w);
            const f32x4 o = s * inv - x;
            u32x2 pk; pk.x = pk2(o[0], o[1]); pk.y = pk2(o[2], o[3]);
            *(u32x2*)(PO + (size_t)(row0 + j) * DPOOL + ch) = pk;
            if (t - w + 1 >= 0) s -= *(const f32x4*)(up + (size_t)(j - w + 1) * DM);
        }
    }
    const float* SP = A->in[3];
    for (size_t it = gtid; it < (size_t)DB * 256; it += nthr) {
        const int qd = (int)(it & 255), b = (int)(it >> 8), ch = qd * 4, w = 2 << (ch >> 8);
        const float* sp = SP + (size_t)b * PBUF * DPOOL + ch;
        const float* up = U + (size_t)(MP + b * 4) * DM + ch;
        f32x4 s = (f32x4){0.f, 0.f, 0.f, 0.f};
        for (int j = 1; j < w; ++j) s += *(const f32x4*)(sp + (size_t)(PBUF - j) * DPOOL);
        const float inv = 1.f / (float)w;
        for (int j = 0; j < 4; ++j) {
            const f32x4 x = *(const f32x4*)(up + (size_t)j * DM);
            s += x;
            const f32x4 o = s * inv - x;
            u32x2 pk; pk.x = pk2(o[0], o[1]); pk.y = pk2(o[2], o[3]);
            *(u32x2*)(PO + (size_t)(MP + b * 4 + j) * DPOOL + ch) = pk;
            const int e = 15 + j - w + 1;
            s -= (e < PBUF) ? *(const f32x4*)(sp + (size_t)e * DPOOL) : *(const f32x4*)(up + (size_t)(e - PBUF) * DM);
        }
    }
    float* out = A->out;
    for (size_t it = gtid; it < (size_t)NB * PBUF * 256; it += nthr) {
        const int qd = (int)(it & 255), r = (int)(it >> 8), b = r / PBUF, j = r % PBUF;
        *(f32x4*)(out + O_PPOOL + (size_t)r * DPOOL + qd * 4) = *(const f32x4*)(U + (size_t)(b * SEQ + SEQ - PBUF + j) * DM + qd * 4);
    }
    for (size_t it = gtid; it < (size_t)DB * PBUF * 256; it += nthr) {
        const int qd = (int)(it & 255), r = (int)(it >> 8), b = r / PBUF, j = r % PBUF;
        const f32x4 v = (j < PBUF - DT) ? *(const f32x4*)(SP + ((size_t)b * PBUF + j + DT) * DPOOL + qd * 4) : *(const f32x4*)(U + (size_t)(MP + b * 4 + (j - (PBUF - DT))) * DM + qd * 4);
        *(f32x4*)(out + O_SPOOL + (size_t)r * DPOOL + qd * 4) = v;
    }
}

constexpr int BU_LD = 132;
constexpr int HB_LD = 136;
constexpr int SSM_WAVE_LDS = 16 * BU_LD * 4 + 16 * HB_LD * 2;

__device__ __forceinline__ float gelu_tanh(float y) { const float t = 1.5957691216f * (y + 0.044715f * y * y * y); return y / (1.f + __expf(-t)); }

__device__ __forceinline__ void ssm_bu_tile(const float* U, int row0, int g, int lane, const bf16x8 (&Bop)[8], LAS float* bu) {
    const int l16 = lane & 15, q = lane >> 4;
    bf16x8 ub = (bf16x8){0, 0, 0, 0, 0, 0, 0, 0};
    if (q < 2) {
        const float* p = U + (size_t)(row0 + l16) * DM + DPOOL + g * CH + 8 * q;
        const f32x4 a = *(const f32x4*)p, b = *(const f32x4*)(p + 4);
        u32x4 w; w.x = pk2(a[0], a[1]); w.y = pk2(a[2], a[3]); w.z = pk2(b[0], b[1]); w.w = pk2(b[2], b[3]);
        ub = __builtin_bit_cast(bf16x8, w);
    }
#pragma unroll
    for (int blk = 0; blk < 8; ++blk) {
        const f32x4 d = __builtin_amdgcn_mfma_f32_16x16x32_bf16(Bop[blk], ub, (f32x4){0.f, 0.f, 0.f, 0.f}, 0, 0, 0);
        *(LAS f32x4*)(bu + l16 * BU_LD + 16 * blk + 4 * q) = d;
    }
}
__device__ __forceinline__ void ssm_y_tile(const float* U, const float* dskip, bf16_t* Z, int row0, int g, int lane, const bf16x8 (&Cop)[4], const LAS bf16_t* hb) {
    const int l16 = lane & 15, q = lane >> 4;
    f32x4 acc = (f32x4){0.f, 0.f, 0.f, 0.f};
#pragma unroll
    for (int kk = 0; kk < 4; ++kk) {
        const bf16x8 b = *(const LAS bf16x8*)(hb + l16 * HB_LD + 32 * kk + 8 * q);
        acc = __builtin_amdgcn_mfma_f32_16x16x32_bf16(Cop[kk], b, acc, 0, 0, 0);
    }
    const int row = row0 + l16, ch = g * CH + 4 * q;
    const f32x4 uu = *(const f32x4*)(U + (size_t)row * DM + DPOOL + ch), dk = *(const f32x4*)(dskip + ch);
    const f32x4 y = acc + dk * uu;
    u32x2 pk; pk.x = pk2(gelu_tanh(y[0]), gelu_tanh(y[1])); pk.y = pk2(gelu_tanh(y[2]), gelu_tanh(y[3]));
    *(u32x2*)(Z + (size_t)row * DSSM + ch) = pk;
}

__device__ __forceinline__ void phase_ssm(LAS unsigned char* lds) {
    const int lane = lane_id(), wave = wave_id();
    ArgP A = argp(); unsigned char* ws = A->ws; const float* U = (const float*)(ws + WS_U); bf16_t* Z = (bf16_t*)(ws + WS_Z);
    const unsigned char* st = ws + WS_SSMT; const float* dskip = A->in[19]; float* out = A->out;
    LAS float* bu = (LAS float*)(lds + wave * SSM_WAVE_LDS);
    LAS bf16_t* hb = (LAS bf16_t*)(lds + wave * SSM_WAVE_LDS + 16 * BU_LD * 4);
    LAS float* xs = (LAS float*)(lds + 8 * SSM_WAVE_LDS);
    for (int task = blockIdx.x; task < NB * NG; task += gridDim.x) {
        const int b = task >> 6, g = task & 63;
        bf16x8 Bop[8], Cop[4];
#pragma unroll
        for (int i = 0; i < 8; ++i) Bop[i] = *(const bf16x8*)(st + ST_BOP + ((size_t)(g * 8 + i) * 64 + lane) * 16);
#pragma unroll
        for (int i = 0; i < 4; ++i) Cop[i] = *(const bf16x8*)(st + ST_COP + ((size_t)(g * 4 + i) * 64 + lane) * 16);
        const float lr = ((const float*)(st + ST_LAM))[2 * (g * 64 + lane)], li = ((const float*)(st + ST_LAM))[2 * (g * 64 + lane) + 1];
        const int rowb = b * SEQ + wave * 256;
        float hr = 0.f, hi = 0.f;
        for (int tl = 0; tl < 16; ++tl) {
            ssm_bu_tile(U, rowb + tl * 16, g, lane, Bop, bu);
#pragma unroll
            for (int j = 0; j < 16; ++j) { const float br = bu[j * BU_LD + lane], bi = bu[j * BU_LD + 64 + lane];
                const float nr = lr * hr - li * hi + br, ni = lr * hi + li * hr + bi; hr = nr; hi = ni; }
        }
        xs[(wave * 64 + lane) * 2] = hr; xs[(wave * 64 + lane) * 2 + 1] = hi;
        __syncthreads();
        float pr = lr, pi = li;
#pragma unroll
        for (int s = 0; s < 8; ++s) { const float a = pr * pr - pi * pi, c = 2.f * pr * pi; pr = a; pi = c; }
        hr = 0.f; hi = 0.f;
        for (int w2 = 0; w2 < wave; ++w2) { const float sr = xs[(w2 * 64 + lane) * 2], si = xs[(w2 * 64 + lane) * 2 + 1];
            const float nr = pr * hr - pi * hi + sr, ni = pr * hi + pi * hr + si; hr = nr; hi = ni; }
        for (int tl = 0; tl < 16; ++tl) {
            ssm_bu_tile(U, rowb + tl * 16, g, lane, Bop, bu);
#pragma unroll
            for (int j = 0; j < 16; ++j) { const float br = bu[j * BU_LD + lane], bi = bu[j * BU_LD + 64 + lane];
                const float nr = lr * hr - li * hi + br, ni = lr * hi + li * hr + bi; hr = nr; hi = ni;
                hb[j * HB_LD + lane] = (bf16_t)f2bf(hr); hb[j * HB_LD + 64 + lane] = (bf16_t)f2bf(hi); }
            ssm_y_tile(U, dskip, Z, rowb + tl * 16, g, lane, Cop, hb);
        }
        if (wave == 7) { out[O_PRE + (size_t)(b * NG + g) * NST + lane] = hr; out[O_PIM + (size_t)(b * NG + g) * NST + lane] = hi; }
        __syncthreads();
    }
    const float* s0r = A->in[4]; const float* s0i = A->in[5];
    for (int task = blockIdx.x * 8 + wave; task < NG * (DB / 4); task += gridDim.x * 8) {
        const int g = task & 63, bq = task >> 6;
        bf16x8 Bop[8], Cop[4];
#pragma unroll
        for (int i = 0; i < 8; ++i) Bop[i] = *(const bf16x8*)(st + ST_BOP + ((size_t)(g * 8 + i) * 64 + lane) * 16);
#pragma unroll
        for (int i = 0; i < 4; ++i) Cop[i] = *(const bf16x8*)(st + ST_COP + ((size_t)(g * 4 + i) * 64 + lane) * 16);
        const float lr = ((const float*)(st + ST_LAM))[2 * (g * 64 + lane)], li = ((const float*)(st + ST_LAM))[2 * (g * 64 + lane) + 1];
        const int row0 = MP + bq * 16;
        ssm_bu_tile(U, row0, g, lane, Bop, bu);
        float hr = 0.f, hi = 0.f;
#pragma unroll
        for (int j = 0; j < 16; ++j) {
            const int bb = bq * 4 + (j >> 2);
            if ((j & 3) == 0) { hr = s0r[(size_t)(bb * NG + g) * NST + lane]; hi = s0i[(size_t)(bb * NG + g) * NST + lane]; }
            const float br = bu[j * BU_LD + lane], bi = bu[j * BU_LD + 64 + lane];
            const float nr = lr * hr - li * hi + br, ni = lr * hi + li * hr + bi; hr = nr; hi = ni;
            hb[j * HB_LD + lane] = (bf16_t)f2bf(hr); hb[j * HB_LD + 64 + lane] = (bf16_t)f2bf(hi);
            if ((j & 3) == 3) { out[O_SRE + (size_t)(bb * NG + g) * NST + lane] = hr; out[O_SIM + (size_t)(bb * NG + g) * NST + lane] = hi; }
        }
        ssm_y_tile(U, dskip, Z, row0, g, lane, Cop, hb);
    }
}

template <bool FINAL>
__device__ __forceinline__ void phase_ln(const float* X, const float* gam, const float* bet, float* O32, bf16_t* O16) {
    const int lane = lane_id(), wave = wave_id();
    const int gw = blockIdx.x * 8 + wave, NGW = gridDim.x * 8;
    for (int row = gw; row < MT; row += NGW) {
        const f32x4* xr = (const f32x4*)(X + (size_t)row * DM) + lane;
        f32x4 v[8]; float s = 0.f;
#pragma unroll
        for (int j = 0; j < 8; ++j) { v[j] = xr[64 * j]; s += (v[j][0] + v[j][1]) + (v[j][2] + v[j][3]); }
        const float mean = wave_sum(s) * (1.f / DM); float s2 = 0.f;
#pragma unroll
        for (int j = 0; j < 8; ++j) { v[j] = v[j] - mean; s2 += (v[j][0] * v[j][0] + v[j][1] * v[j][1]) + (v[j][2] * v[j][2] + v[j][3] * v[j][3]); }
        const float rstd = 1.f / sqrtf(wave_sum(s2) * (1.f / DM) + LN_EPS);
#pragma unroll
        for (int j = 0; j < 8; ++j) {
            const f32x4 gg = ((const f32x4*)gam)[lane + 64 * j], bb = ((const f32x4*)bet)[lane + 64 * j];
            const f32x4 o = v[j] * rstd * gg + bb;
            ((f32x4*)(O32 + (size_t)row * DM))[lane + 64 * j] = o;
            if (!FINAL) { u32x2 pk; pk.x = pk2(o[0], o[1]); pk.y = pk2(o[2], o[3]); ((u32x2*)(O16 + (size_t)row * DM))[lane + 64 * j] = pk; }
        }
    }
}

__device__ __forceinline__ void phase_softmax(const float* S, bf16_t* P) {
    const int lane = lane_id(), wave = wave_id();
    const int gw = blockIdx.x * 8 + wave, NGW = gridDim.x * 8;
    for (int row = gw; row < NB * NH * SEQ; row += NGW) {
        const f32x4 v = ((const f32x4*)(S + (size_t)row * NMEM))[lane];
        const float mx = wave_max(fmaxf(fmaxf(v[0], v[1]), fmaxf(v[2], v[3])));
        const float e0 = __expf(v[0] - mx), e1 = __expf(v[1] - mx), e2 = __expf(v[2] - mx), e3 = __expf(v[3] - mx);
        const float inv = 1.f / wave_sum((e0 + e1) + (e2 + e3));
        u32x2 pk; pk.x = pk2(e0 * inv, e1 * inv); pk.y = pk2(e2 * inv, e3 * inv);
        ((u32x2*)(P + (size_t)row * NMEM))[lane] = pk;
    }
}

__device__ __forceinline__ void phase_attn_sample(LAS unsigned char* lds) {
    const int lane = lane_id(), wave = wave_id();
    ArgP A = argp();
    const bf16_t* Q = (const bf16_t*)(A->ws + WS_Q); bf16_t* AO = (bf16_t*)(A->ws + WS_AO);
    const float* CK = A->in[7]; const float* CV = A->in[8];
    LAS float* sS = (LAS float*)lds;
    LAS float* sP = (LAS float*)(lds + 4096);
    LAS float* sR = (LAS float*)(lds + 8192);
    const int l16 = lane & 15, q = lane >> 4;
    for (int task = blockIdx.x; task < DB * NH; task += gridDim.x) {
        const int b = task >> 2, h = task & 3;
        f32x4 sacc[2] = {(f32x4){0.f, 0.f, 0.f, 0.f}, (f32x4){0.f, 0.f, 0.f, 0.f}};
        const bf16_t* qrow = Q + (size_t)(MP + b * 4 + (l16 & 3)) * DM + h * HD + 4 * q;
        const float* k0p = CK + ((size_t)(b * NMEM + wave * 32 + l16) * NH + h) * HD + 4 * q;
        const float* k1p = k0p + (size_t)16 * NH * HD;
#pragma unroll 4
        for (int ks = 0; ks < 16; ++ks) {
            u32x2 qa = *(const u32x2*)(qrow + 32 * ks), qb = *(const u32x2*)(qrow + 32 * ks + 16);
            if (l16 >= 4) { qa = (u32x2){0u, 0u}; qb = (u32x2){0u, 0u}; }
            const u32x4 aw = (u32x4){qa.x, qa.y, qb.x, qb.y};
            const f32x4 x0 = __builtin_nontemporal_load((const f32x4*)(k0p + 32 * ks)), x1 = __builtin_nontemporal_load((const f32x4*)(k0p + 32 * ks + 16));
            const f32x4 y0 = __builtin_nontemporal_load((const f32x4*)(k1p + 32 * ks)), y1 = __builtin_nontemporal_load((const f32x4*)(k1p + 32 * ks + 16));
            u32x4 bw0, bw1;
            bw0.x = pk2(x0[0], x0[1]); bw0.y = pk2(x0[2], x0[3]); bw0.z = pk2(x1[0], x1[1]); bw0.w = pk2(x1[2], x1[3]);
            bw1.x = pk2(y0[0], y0[1]); bw1.y = pk2(y0[2], y0[3]); bw1.z = pk2(y1[0], y1[1]); bw1.w = pk2(y1[2], y1[3]);
            sacc[0] = __builtin_amdgcn_mfma_f32_16x16x32_bf16(__builtin_bit_cast(bf16x8, aw), __builtin_bit_cast(bf16x8, bw0), sacc[0], 0, 0, 0);
            sacc[1] = __builtin_amdgcn_mfma_f32_16x16x32_bf16(__builtin_bit_cast(bf16x8, aw), __builtin_bit_cast(bf16x8, bw1), sacc[1], 0, 0, 0);
        }
        if (q == 0) {
#pragma unroll
            for (int t = 0; t < 4; ++t) { sS[t * 256 + wave * 32 + l16] = sacc[0][t]; sS[t * 256 + wave * 32 + 16 + l16] = sacc[1][t]; }
        }
        __syncthreads();
        if (wave < 4) {
            const f32x4 v = *(LAS f32x4*)(sS + wave * 256 + 4 * lane);
            const float mx = wave_max(fmaxf(fmaxf(v[0], v[1]), fmaxf(v[2], v[3])));
            const float e0 = __expf(v[0] - mx), e1 = __expf(v[1] - mx), e2 = __expf(v[2] - mx), e3 = __expf(v[3] - mx);
            const float inv = 1.f / wave_sum((e0 + e1) + (e2 + e3));
            sP[(4 * lane + 0) * 4 + wave] = e0 * inv; sP[(4 * lane + 1) * 4 + wave] = e1 * inv; sP[(4 * lane + 2) * 4 + wave] = e2 * inv; sP[(4 * lane + 3) * 4 + wave] = e3 * inv;
        }
        __syncthreads();
        f32x4 o0[4], o1[4];
#pragma unroll
        for (int t = 0; t < 4; ++t) { o0[t] = (f32x4){0.f, 0.f, 0.f, 0.f}; o1[t] = (f32x4){0.f, 0.f, 0.f, 0.f}; }
        const float* vp = CV + ((size_t)(b * NMEM + wave * 32) * NH + h) * HD + 4 * lane;
#pragma unroll 8
        for (int kx = 0; kx < 32; ++kx) {
            const f32x4 v0 = __builtin_nontemporal_load((const f32x4*)(vp + (size_t)kx * NH * HD)), v1 = __builtin_nontemporal_load((const f32x4*)(vp + (size_t)kx * NH * HD + 256));
            const f32x4 p = *(LAS f32x4*)(sP + (wave * 32 + kx) * 4);
#pragma unroll
            for (int t = 0; t < 4; ++t) { o0[t] += v0 * p[t]; o1[t] += v1 * p[t]; }
        }
#pragma unroll
        for (int t = 0; t < 4; ++t) { *(LAS f32x4*)(sR + (wave * 4 + t) * 512 + 4 * lane) = o0[t]; *(LAS f32x4*)(sR + (wave * 4 + t) * 512 + 256 + 4 * lane) = o1[t]; }
        __syncthreads();
        {
            const int t = threadIdx.x >> 7, d4 = (threadIdx.x & 127) * 4;
            f32x4 s = (f32x4){0.f, 0.f, 0.f, 0.f};
#pragma unroll
            for (int w2 = 0; w2 < 8; ++w2) s += *(LAS f32x4*)(sR + (w2 * 4 + t) * 512 + d4);
            u32x2 pk; pk.x = pk2(s[0], s[1]); pk.y = pk2(s[2], s[3]);
            *(u32x2*)(AO + (size_t)(MP + b * 4 + t) * DM + h * HD + d4) = pk;
        }
        __syncthreads();
    }
}

__device__ __forceinline__ void phase_act() {
    ArgP A = argp();
    const bf16_t* GU = (const bf16_t*)(A->ws + WS_GU); bf16_t* ACT = (bf16_t*)(A->ws + WS_ACT);
    const float* cw = A->in[33]; const float* cb = A->in[34]; const float* sc = A->in[6];
    const size_t gtid = (size_t)blockIdx.x * 512 + threadIdx.x, nthr = (size_t)gridDim.x * 512;
    constexpr int FG = DFF / 8;
    for (size_t it = gtid; it < (size_t)MT * FG; it += nthr) {
        const int fg = (int)(it % FG), row = (int)(it / FG), f0 = fg * 8;
        float g0[8], g1[8], g2[8], up[8];
        { const u32x4 w = *(const u32x4*)(GU + (size_t)row * (2 * DFF) + f0);
          g2[0] = bf2f(w.x & 0xffffu); g2[1] = bf2f(w.x >> 16); g2[2] = bf2f(w.y & 0xffffu); g2[3] = bf2f(w.y >> 16); g2[4] = bf2f(w.z & 0xffffu); g2[5] = bf2f(w.z >> 16); g2[6] = bf2f(w.w & 0xffffu); g2[7] = bf2f(w.w >> 16); }
        { const u32x4 w = *(const u32x4*)(GU + (size_t)row * (2 * DFF) + DFF + f0);
          up[0] = bf2f(w.x & 0xffffu); up[1] = bf2f(w.x >> 16); up[2] = bf2f(w.y & 0xffffu); up[3] = bf2f(w.y >> 16); up[4] = bf2f(w.z & 0xffffu); up[5] = bf2f(w.z >> 16); up[6] = bf2f(w.w & 0xffffu); up[7] = bf2f(w.w >> 16); }
        int t; const float* sb = nullptr;
        if (row < MP) t = row & (SEQ - 1); else { const int r = row - MP; t = r & 3; sb = sc + (size_t)(r >> 2) * 2 * DFF + f0; }
#pragma unroll
        for (int d = 1; d <= 2; ++d) {
            float* gd = (d == 1) ? g1 : g0;
            if (t - d >= 0) { const u32x4 w = *(const u32x4*)(GU + (size_t)(row - d) * (2 * DFF) + f0);
                gd[0] = bf2f(w.x & 0xffffu); gd[1] = bf2f(w.x >> 16); gd[2] = bf2f(w.y & 0xffffu); gd[3] = bf2f(w.y >> 16); gd[4] = bf2f(w.z & 0xffffu); gd[5] = bf2f(w.z >> 16); gd[6] = bf2f(w.w & 0xffffu); gd[7] = bf2f(w.w >> 16); }
            else if (sb) { const float* p = sb + (size_t)(2 + t - d) * DFF; const f32x4 a = *(const f32x4*)p, b = *(const f32x4*)(p + 4);
                gd[0] = a[0]; gd[1] = a[1]; gd[2] = a[2]; gd[3] = a[3]; gd[4] = b[0]; gd[5] = b[1]; gd[6] = b[2]; gd[7] = b[3]; }
            else {
#pragma unroll
                for (int e = 0; e < 8; ++e) gd[e] = 0.f; }
        }
        float o[8];
#pragma unroll
        for (int e = 0; e < 8; ++e) {
            const float gc = cb[f0 + e] + g0[e] * cw[f0 + e] + g1[e] * cw[DFF + f0 + e] + g2[e] * cw[2 * DFF + f0 + e];
            o[e] = gc / (1.f + __expf(-gc)) * up[e];
        }
        u32x4 w; w.x = pk2(o[0], o[1]); w.y = pk2(o[2], o[3]); w.z = pk2(o[4], o[5]); w.w = pk2(o[6], o[7]);
        *(u32x4*)(ACT + (size_t)row * DFF + f0) = w;
    }
}

constexpr int N_PHASES = 16;
__global__ void __launch_bounds__(512, 2) fwd_megakernel(Args args) {
    extern __shared__ __attribute__((aligned(16))) unsigned char lds_raw[];
    LAS unsigned char* lds = (LAS unsigned char*)lds_raw;
    const int G = gridDim.x, c0 = blockIdx.x;
    unsigned char* const ws = argp()->ws;
    const int lo = argp()->ph_lo, hi = argp()->ph_hi;
#define out (argp()->out)
    cg::grid_group grid = cg::this_grid();
    if (threadIdx.x < 4) ((LAS unsigned*)(lds + LDS_BYTES - 16))[threadIdx.x] = 0u;
    __syncthreads();
    XcdBarrier bar = xcd_barrier_post((unsigned*)ws, (volatile LAS unsigned*)(lds + LDS_BYTES - 16));
    if (hi > N_PHASES) grid.sync();
#define IN(k) (lo <= (k) && (k) < hi)
#define SEAM(k) do { if (IN(k) && IN((k) + 1)) xcd_barrier(bar); } while (0)
    using namespace pg8;
    const bf16_t* XB = (const bf16_t*)(ws + WS_XB);

    if (IN(0)) { phase_prep(lds); }
    SEAM(0);
    if (IN(1)) {
        {
            GridSched S{(const char*)XB, (const char*)(ws + WS_WIN), (long)256 * DM * 2, 0, (long)256 * DM * 2, MP / 256, DM / 256, (MP / 256) * (DM / 256), G, c0};
            EpiStore E{(float*)(ws + WS_U), nullptr, DM, 0, 0, 1.f, nullptr};
            gemm_phase(lds, Dims{DM, DM, DM}, S, E);
        }
        skinny_gemm(lds, XB + (size_t)MP * DM, DM, (const bf16_t*)(ws + WS_WIN), DM, DM, SkStore{(float*)(ws + WS_U) + (size_t)MP * DM, nullptr, 1.f});
    }
    SEAM(1);
    if (IN(2)) { phase_pool(); phase_ssm(lds); }
    SEAM(2);
    if (IN(3)) {
        {
            GridSched S{(const char*)(ws + WS_MEMB), (const char*)(ws + WS_WKV), (long)256 * DM * 2, 0, (long)256 * DM * 2, 4, 16, 64, G, c0};
            EpiStore E{out + O_PMK, (bf16_t*)(ws + WS_KB), DM, DM, (size_t)NB * NMEM * DM, 1.f, nullptr};
            gemm_phase(lds, Dims{DM, DM, DM}, S, E);
        }
        {
            GridSched S{(const char*)(ws + WS_WKV) + (size_t)DM * DM * 2, (const char*)(ws + WS_MEMB), (long)256 * DM * 2, 0, (long)256 * DM * 2, 8, 4, 32, G, (c0 + G - 64) % G};
            EpiStore E{nullptr, (bf16_t*)(ws + WS_VT), NB * NMEM, 0, 0, 1.f, nullptr};
            gemm_phase(lds, Dims{DM, DM, DM}, S, E);
        }
        {
            GridSched S{(const char*)(ws + WS_Z), (const char*)(ws + WS_WGLU), (long)256 * DSSM * 2, 0, (long)256 * DSSM * 2, MT / 256, 4, (MT / 256) * 4, G, (c0 + G - 96) % G};
            EpiGlu E{(const bf16_t*)(ws + WS_Z), argp()->in[21], (bf16_t*)(ws + WS_MIX)};
            gemm_phase(lds, Dims{DSSM, DSSM, DSSM}, S, E);
        }
        {
            GridSched S{(const char*)(ws + WS_POOLED), (const char*)(ws + WS_WPOOL), (long)256 * DPOOL * 2, (long)256 * 2, (long)256 * 256 * 2, MT / 256, 4, (MT / 256) * 4, G, (c0 + G - 96) % G};
            EpiStore E{nullptr, (bf16_t*)(ws + WS_MIX), DM, 0, 0, 1.f, argp()->in[11]};
            gemm_phase(lds, Dims{DPOOL, 256, 256}, S, E);
        }
    }
    SEAM(3);
    if (IN(4)) {
        GridSched S{(const char*)(ws + WS_MIX), (const char*)(ws + WS_WOUT), (long)256 * DM * 2, 0, (long)256 * DM * 2, MP / 256, DM / 256, (MP / 256) * (DM / 256), G, c0};
        EpiResid E{argp()->in[0], argp()->in[1], (float*)(ws + WS_PRE)};
        gemm_phase(lds, Dims{DM, DM, DM}, S, E);
        skinny_gemm(lds, (const bf16_t*)(ws + WS_MIX) + (size_t)MP * DM, DM, (const bf16_t*)(ws + WS_WOUT), DM, DM, SkResid{argp()->in[1], (float*)(ws + WS_PRE) + (size_t)MP * DM});
    }
    SEAM(4);
    if (IN(5)) { phase_ln<false>((const float*)(ws + WS_PRE), argp()->in[23], argp()->in[24], (float*)(ws + WS_H1), (bf16_t*)(ws + WS_HB)); }
    SEAM(5);
    if (IN(6)) {
        GridSched S{(const char*)(ws + WS_HB), (const char*)(ws + WS_WQ), (long)256 * DM * 2, 0, (long)256 * DM * 2, MP / 256, DM / 256, (MP / 256) * (DM / 256), G, c0};
        EpiStore E{nullptr, (bf16_t*)(ws + WS_Q), DM, 0, 0, QSCALE, nullptr};
        gemm_phase(lds, Dims{DM, DM, DM}, S, E);
        skinny_gemm(lds, (const bf16_t*)(ws + WS_HB) + (size_t)MP * DM, DM, (const bf16_t*)(ws + WS_WQ), DM, DM, SkStore{nullptr, (bf16_t*)(ws + WS_Q) + (size_t)MP * DM, QSCALE});
    }
    SEAM(6);
    if (IN(7)) {
        {
            SchedS S{(const char*)(ws + WS_Q), (const char*)(ws + WS_KB), G, c0};
            EpiStore E{(float*)(ws + WS_S), nullptr, NMEM, 0, 0, 1.f, nullptr};
            gemm_phase(lds, Dims{DM, DM, HD}, S, E);
        }
        phase_attn_sample(lds);
    }
    SEAM(7);
    if (IN(8)) { phase_softmax((const float*)(ws + WS_S), (bf16_t*)(ws + WS_P)); }
    SEAM(8);
    if (IN(9)) {
        SchedPV S{(const char*)(ws + WS_P), (const char*)(ws + WS_VT), G, c0};
        EpiStore E{nullptr, (bf16_t*)(ws + WS_AO), DM, 0, 0, 1.f, nullptr};
        gemm_phase(lds, Dims{NMEM, NB * NMEM, NMEM}, S, E);
    }
    SEAM(9);
    if (IN(10)) {
        GridSched S{(const char*)(ws + WS_AO), (const char*)(ws + WS_WO), (long)256 * DM * 2, 0, (long)256 * DM * 2, MP / 256, DM / 256, (MP / 256) * (DM / 256), G, c0};
        EpiResid E{(const float*)(ws + WS_H1), (const float*)(ws + WS_H1) + (size_t)MP * DM, (float*)(ws + WS_PRE)};
        gemm_phase(lds, Dims{DM, DM, DM}, S, E);
        skinny_gemm(lds, (const bf16_t*)(ws + WS_AO) + (size_t)MP * DM, DM, (const bf16_t*)(ws + WS_WO), DM, DM, SkResid{(const float*)(ws + WS_H1) + (size_t)MP * DM, (float*)(ws + WS_PRE) + (size_t)MP * DM});
    }
    SEAM(10);
    if (IN(11)) { phase_ln<false>((const float*)(ws + WS_PRE), argp()->in[29], argp()->in[30], (float*)(ws + WS_H2), (bf16_t*)(ws + WS_HB)); }
    SEAM(11);
    if (IN(12)) {
        GridSched S{(const char*)(ws + WS_HB), (const char*)(ws + WS_WGU), (long)256 * DM * 2, 0, (long)256 * DM * 2, MT / 256, 2 * DFF / 256, (MT / 256) * (2 * DFF / 256), G, c0};
        EpiGateUp E{(bf16_t*)(ws + WS_GU), out + O_PCONV, out + O_SCONV};
        gemm_phase(lds, Dims{DM, DM, DM}, S, E);
    }
    SEAM(12);
    if (IN(13)) { phase_act(); }
    SEAM(13);
    if (IN(14)) {
        GridSched S{(const char*)(ws + WS_ACT), (const char*)(ws + WS_WDOWN), (long)256 * DFF * 2, 0, (long)256 * DFF * 2, MP / 256, DM / 256, (MP / 256) * (DM / 256), G, c0};
        EpiResid E{(const float*)(ws + WS_H2), (const float*)(ws + WS_H2) + (size_t)MP * DM, (float*)(ws + WS_PRE)};
        gemm_phase(lds, Dims{DFF, DFF, DFF}, S, E);
        skinny_gemm(lds, (const bf16_t*)(ws + WS_ACT) + (size_t)MP * DFF, DFF, (const bf16_t*)(ws + WS_WDOWN), DFF, DFF, SkResid{(const float*)(ws + WS_H2) + (size_t)MP * DM, (float*)(ws + WS_PRE) + (size_t)MP * DM});
    }
    SEAM(14);
    if (IN(15)) { phase_ln<true>((const float*)(ws + WS_PRE), argp()->in[36], argp()->in[37], out + O_Y, nullptr); }
#undef IN
#undef SEAM
#undef out
}

extern "C" void kernel_launch(void* const* d_in, const int* in_sizes, int n_in, void* d_out, int out_size, void* d_ws, size_t ws_size, hipStream_t stream) {
    static int grid = 0;
    if (grid == 0) {
        if (n_in != 38 || (size_t)out_size != O_END || ws_size < WS_END) { fprintf(stderr, "kernel_launch: unexpected shapes: n_in %d out %d (want %zu) ws %zu (want %zu)\n", n_in, out_size, (size_t)O_END, ws_size, (size_t)WS_END); grid = -1; return; }
        int dev = 0, cus = 0, per_cu = 0;
        hipGetDevice(&dev);
        hipDeviceGetAttribute(&cus, hipDeviceAttributeMultiprocessorCount, dev);
        if (hipFuncSetAttribute((const void*)fwd_megakernel, hipFuncAttributeMaxDynamicSharedMemorySize, LDS_BYTES) != hipSuccess) { fprintf(stderr, "kernel_launch: hipFuncSetAttribute failed\n"); grid = -1; return; }
        if (hipOccupancyMaxActiveBlocksPerMultiprocessor(&per_cu, (const void*)fwd_megakernel, 512, LDS_BYTES) != hipSuccess || per_cu < 1) { fprintf(stderr, "kernel_launch: occupancy query says %d\n", per_cu); per_cu = 1; }
        (void)hipGetLastError();
        grid = cus * (per_cu > 1 ? 1 : per_cu);
        fprintf(stderr, "kernel_launch: grid %d (cus %d, per_cu %d)\n", grid, cus, per_cu);
    }
    if (grid < 0) return;
    Args a{};
    for (int i = 0; i < 38; ++i) a.in[i] = (const float*)d_in[i];
    a.out = (float*)d_out; a.ws = (unsigned char*)d_ws;
#if MK_PER_PHASE_LAUNCH
    for (int p = 0; p < N_PHASES; ++p) {
        a.ph_lo = p; a.ph_hi = p + 1;
        hipLaunchKernelGGL(fwd_megakernel, dim3(grid), dim3(512), LDS_BYTES, stream, a);
    }
#else
    a.ph_lo = 0; a.ph_hi = N_PHASES;
    if (hipMemsetAsync(d_ws, 0, 16384, stream) != hipSuccess) { fprintf(stderr, "kernel_launch: memset failed\n"); return; }
    void* kargs[] = {&a};
    hipError_t e = hipLaunchCooperativeKernel((const void*)fwd_megakernel, dim3(grid), dim3(512), kargs, LDS_BYTES, stream);
    if (e != hipSuccess) fprintf(stderr, "kernel_launch: cooperative launch failed: %s (grid %d)\n", hipGetErrorString(e), grid);
#endif
}
```

```cpp
#include <hip/hip_runtime.h>
#include <hip/hip_cooperative_groups.h>
#include <cstdio>
#include <cstdint>
namespace cg = cooperative_groups;

#ifndef MK_PER_PHASE_LAUNCH
#define MK_PER_PHASE_LAUNCH 0
#endif

#define LAS __attribute__((address_space(3)))
typedef unsigned short bf16_t;
typedef short bf16x8 __attribute__((ext_vector_type(8)));
typedef float f32x4 __attribute__((ext_vector_type(4)));
typedef float f32x2 __attribute__((ext_vector_type(2)));
typedef unsigned u32x4 __attribute__((ext_vector_type(4)));
typedef unsigned u32x2 __attribute__((ext_vector_type(2)));

constexpr int DM = 2048, NB = 4, SEQ = 2048, DB = 128, DT = 4;
constexpr int MP = NB * SEQ, MS = DB * DT, MT = MP + MS;
constexpr int DPOOL = 1024, DSSM = 1024, PBUF = 15, NG = 64, NST = 64, CH = 16;
constexpr int NMEM = 256, NH = 4, HD = 512, DFF = 5632;
constexpr float ALPHA = 1.189207115002721f;
constexpr float LN_EPS = 1e-5f;
constexpr float QSCALE = 0.04419417382415922f;

constexpr size_t O_Y = 0;
constexpr size_t O_PPOOL = (size_t)MT * DM;
constexpr size_t O_PRE = O_PPOOL + (size_t)NB * PBUF * DPOOL;
constexpr size_t O_PIM = O_PRE + (size_t)NB * NG * NST;
constexpr size_t O_PCONV = O_PIM + (size_t)NB * NG * NST;
constexpr size_t O_PMK = O_PCONV + (size_t)NB * 2 * DFF;
constexpr size_t O_PMV = O_PMK + (size_t)NB * NMEM * DM;
constexpr size_t O_SPOOL = O_PMV + (size_t)NB * NMEM * DM;
constexpr size_t O_SRE = O_SPOOL + (size_t)DB * PBUF * DPOOL;
constexpr size_t O_SIM = O_SRE + (size_t)DB * NG * NST;
constexpr size_t O_SCONV = O_SIM + (size_t)DB * NG * NST;
constexpr size_t O_END = O_SCONV + (size_t)DB * 2 * DFF;

constexpr size_t MiB = 1u << 20;
constexpr size_t WS_WIN = 1 * MiB;
constexpr size_t WS_WKV = WS_WIN + 8 * MiB;
constexpr size_t WS_WPOOL = WS_WKV + 16 * MiB;
constexpr size_t WS_WGLU = WS_WPOOL + 1 * MiB;
constexpr size_t WS_WOUT = WS_WGLU + 2 * MiB;
constexpr size_t WS_WQ = WS_WOUT + 8 * MiB;
constexpr size_t WS_WO = WS_WQ + 8 * MiB;
constexpr size_t WS_WGU = WS_WO + 8 * MiB;
constexpr size_t WS_WDOWN = WS_WGU + 44 * MiB;
constexpr size_t WS_SSMT = WS_WDOWN + 22 * MiB;
constexpr size_t WS_XB = WS_SSMT + 1 * MiB;
constexpr size_t WS_MEMB = WS_XB + 34 * MiB;
constexpr size_t WS_U = WS_MEMB + 4 * MiB;
constexpr size_t WS_POOLED = WS_U + 68 * MiB;
constexpr size_t WS_Z = WS_POOLED + 17 * MiB;
constexpr size_t WS_MIX = WS_Z + 17 * MiB;
constexpr size_t WS_PRE = WS_MIX + 34 * MiB;
constexpr size_t WS_H1 = WS_PRE + 68 * MiB;
constexpr size_t WS_H2 = WS_H1 + 68 * MiB;
constexpr size_t WS_HB = WS_H2 + 68 * MiB;
constexpr size_t WS_Q = WS_HB + 34 * MiB;
constexpr size_t WS_KB = WS_Q + 34 * MiB;
constexpr size_t WS_VT = WS_KB + 8 * MiB;
constexpr size_t WS_S = WS_VT + 4 * MiB;
constexpr size_t WS_P = WS_S + 32 * MiB;
constexpr size_t WS_AO = WS_P + 16 * MiB;
constexpr size_t WS_GU = WS_AO + 34 * MiB;
constexpr size_t WS_ACT = WS_GU + 187 * MiB;
constexpr size_t WS_END = WS_ACT + 94 * MiB;
constexpr size_t ST_BOP = 0;
constexpr size_t ST_COP = 512 * 1024;
constexpr size_t ST_LAM = 768 * 1024;

constexpr int LDS_BYTES = 147456;

__device__ __forceinline__ unsigned f2bf(float f) { unsigned u = __builtin_bit_cast(unsigned, f); return (u + 0x7fffu + ((u >> 16) & 1u)) >> 16; }
__device__ __forceinline__ unsigned pk2(float lo, float hi) { return f2bf(lo) | (f2bf(hi) << 16); }
__device__ __forceinline__ float bf2f(unsigned h) { return __builtin_bit_cast(float, h << 16); }
__device__ __forceinline__ float wave_sum(float v) {
#pragma unroll
    for (int o = 1; o < 64; o <<= 1) v += __shfl_xor(v, o);
    return v;
}
__device__ __forceinline__ float wave_max(float v) {
#pragma unroll
    for (int o = 1; o < 64; o <<= 1) v = fmaxf(v, __shfl_xor(v, o));
    return v;
}

__device__ __forceinline__ int lane_id() { int l = threadIdx.x & 63; asm volatile("" : "+v"(l)); return l; }
__device__ __forceinline__ int wave_id() { int t = threadIdx.x; asm volatile("" : "+v"(t)); return __builtin_amdgcn_readfirstlane(t >> 6); }

namespace pg8 {
constexpr int BM = 256, BK = 64, HALF = 128, HTB = HALF * BK * 2, STAGE_BYTES = 8 * HTB, NXCD = 8, WGM = 8;
__device__ __forceinline__ int lds_byte(int r, int c) { const int st = (r >> 4) * 2 + (c >> 5), rr = r & 15, cc = c & 31, ob = rr * 64 + cc * 2; return st * 1024 + (ob ^ (((ob >> 9) & 1) << 5)); }
__device__ __forceinline__ void stage_rc(int b, int& R, int& C) { const int st = b / 1024, sb = b % 1024, swz = sb ^ (((sb >> 9) & 1) << 5); R = (st >> 1) * 16 + swz / 64; C = (st & 1) * 32 + (swz % 64) / 2; }
__device__ __forceinline__ int perm32(int rho) { const int n = rho >> 4, i = rho & 15; return 8 * (i >> 2) + 4 * n + (i & 3); }

struct Unit { const char* a; const char* b; int row0, col0; };
struct Dims { int lda, ldb, K; };

struct GridSched {
    const char* A; const char* B; long a_pm, a_pn, b_pn; int nM, nN, nwg, G, c;
    __device__ __forceinline__ bool next(int i, Unit& u) const {
        const long L = (long)i * G + c; if (L >= nwg) return false;
        int wgid = (int)L; { const int q = nwg / NXCD, r = nwg % NXCD, xcd = wgid % NXCD, off = wgid / NXCD; wgid = (xcd < r ? xcd * (q + 1) : r * (q + 1) + (xcd - r) * q) + off; }
        const int nig = WGM * nN, gid = wgid / nig, fm = gid * WGM, gsz = (nM - fm) < WGM ? (nM - fm) : WGM;
        const int pm = fm + ((wgid % nig) % gsz), pn = (wgid % nig) / gsz;
        u.a = A + pm * a_pm + pn * a_pn; u.b = B + pn * b_pn; u.row0 = pm * BM; u.col0 = pn * BM; return true;
    }
};

template <class Epi, class Sched>
__device__ __forceinline__ void gemm_phase(LAS unsigned char* lds, const Dims g, const Sched& S, const Epi& E) {
    const int tid = threadIdx.x, wid = __builtin_amdgcn_readfirstlane(tid >> 6), lane = tid & 63, wr = wid >> 2, wc = wid & 3, fr = lane & 15, fq = lane >> 4;
    const int K = g.K, nt = K / BK;
    unsigned voffA[2], voffB[2];
#pragma unroll
    for (int i = 0; i < 2; ++i) { int R, C; stage_rc(tid * 16 + i * 8192, R, C); const int Rb = (R & ~31) + perm32(R & 31);
        voffA[i] = (unsigned)(R * g.lda + C) * 2u; voffB[i] = (unsigned)(Rb * g.ldb + C) * 2u; }
    const size_t kstep = (size_t)(BK * 2);
    const size_t hstepA = (size_t)HALF * g.lda * 2, hstepB = (size_t)HALF * g.ldb * 2;
    const unsigned ldsw = (unsigned)wid * 1024u;
    const int aoff = lds_byte(wr * 64 + fr, fq * 8), boff = lds_byte(wc * 32 + fr, fq * 8);
#define PG8_SA(b, h) (((b) * 2 + (h)) * HTB)
#define PG8_SB(b, h) ((4 + (b) * 2 + (h)) * HTB)
#define PG8_STAGE(bufoff, gbase, voff) do { _Pragma("unroll") for (int _i = 0; _i < 2; ++_i) \
        __builtin_amdgcn_global_load_lds((const unsigned*)((const char*)(gbase) + (voff)[_i]), (LAS unsigned*)(lds + (bufoff) + ldsw + _i * 8192), 16, 0, 0); } while (0)
#define PG8_LDA(dst, b, h) do { _Pragma("unroll") for (int m = 0; m < 4; ++m) _Pragma("unroll") for (int k = 0; k < 2; ++k) dst[m][k] = *(const LAS bf16x8*)(lds + PG8_SA(b, h) + aoff + m * 2048 + k * 1024); } while (0)
#define PG8_LDB(dst, b, h) do { _Pragma("unroll") for (int n = 0; n < 2; ++n) _Pragma("unroll") for (int k = 0; k < 2; ++k) dst[n][k] = *(const LAS bf16x8*)(lds + PG8_SB(b, h) + boff + n * 2048 + k * 1024); } while (0)
#define PG8_MMA(ai, bj, At, Bt) do { __builtin_amdgcn_s_setprio(1); _Pragma("unroll") for (int m = 0; m < 4; ++m) _Pragma("unroll") for (int n = 0; n < 2; ++n) _Pragma("unroll") for (int k = 0; k < 2; ++k) \
        acc[ai][bj][m][n] = __builtin_amdgcn_mfma_f32_16x16x32_bf16(Bt[n][k], At[m][k], acc[ai][bj][m][n], 0, 0, 0); __builtin_amdgcn_s_setprio(0); } while (0)
#define PG8_WAIT_V(n) asm volatile("s_waitcnt vmcnt(" #n ")" ::: "memory")
#define PG8_WAIT_L(n) asm volatile("s_waitcnt lgkmcnt(" #n ")" ::: "memory")
#define PG8_BAR __builtin_amdgcn_s_barrier()
#define PG8_SCHED __builtin_amdgcn_sched_barrier(0)
    Unit cur, nxt; int ui = 0;
    if (!S.next(0, cur)) return;
    f32x4 acc[2][2][4][2];
#pragma unroll
    for (int a = 0; a < 2; ++a)
#pragma unroll
        for (int b = 0; b < 2; ++b)
#pragma unroll
            for (int m = 0; m < 4; ++m)
#pragma unroll
                for (int n = 0; n < 2; ++n) acc[a][b][m][n] = (f32x4){0.f, 0.f, 0.f, 0.f};
    bf16x8 At[4][2], B0[2][2], B1[2][2];
    const char* cA = cur.a; const char* cB = cur.b;
    PG8_STAGE(PG8_SB(0, 0), cB, voffB); PG8_STAGE(PG8_SB(0, 1), cB + hstepB, voffB); PG8_STAGE(PG8_SA(0, 0), cA, voffA); PG8_STAGE(PG8_SA(0, 1), cA + hstepA, voffA);
    if (wr == 1) PG8_BAR;
    PG8_WAIT_V(2); PG8_BAR;
    PG8_STAGE(PG8_SB(1, 0), cB + kstep, voffB); PG8_STAGE(PG8_SA(1, 0), cA + kstep, voffA); PG8_STAGE(PG8_SB(1, 1), cB + hstepB + kstep, voffB);
    PG8_WAIT_V(6); PG8_BAR;
    for (;;) {
        const bool has_next = S.next(ui + 1, nxt);
        const char* nA = has_next ? nxt.a : cA; const char* nB = has_next ? nxt.b : cB;
        for (int t = 0; t < nt; t += 2) {
            const bool last = (t == nt - 2);
            const char* a1 = cA + (size_t)(t + 1) * kstep;
            const char* a2 = last ? nA : cA + (size_t)(t + 2) * kstep; const char* b2 = last ? nB : cB + (size_t)(t + 2) * kstep;
            const char* a3 = a2 + kstep; const char* b3 = b2 + kstep;
            PG8_LDB(B0, 0, 0); PG8_LDB(B1, 0, 1); PG8_SCHED; PG8_LDA(At, 0, 0); PG8_STAGE(PG8_SA(1, 1), a1 + hstepA, voffA);
            PG8_WAIT_V(8); PG8_WAIT_L(0); PG8_BAR; PG8_MMA(0, 0, At, B0); PG8_MMA(0, 1, At, B1); PG8_BAR; PG8_SCHED;
            PG8_LDA(At, 0, 1); PG8_STAGE(PG8_SB(0, 0), b2, voffB); PG8_STAGE(PG8_SB(0, 1), b2 + hstepB, voffB); PG8_STAGE(PG8_SA(0, 0), a2, voffA);
            PG8_WAIT_V(8); PG8_WAIT_L(0); PG8_BAR; PG8_MMA(1, 0, At, B0); PG8_MMA(1, 1, At, B1); PG8_BAR; PG8_SCHED;
            PG8_LDB(B0, 1, 0); PG8_LDB(B1, 1, 1); PG8_SCHED; PG8_LDA(At, 1, 0); PG8_STAGE(PG8_SA(0, 1), a2 + hstepA, voffA);
            PG8_WAIT_V(8); PG8_WAIT_L(0); PG8_BAR; PG8_MMA(0, 0, At, B0); PG8_MMA(0, 1, At, B1); PG8_BAR; PG8_SCHED;
            PG8_LDA(At, 1, 1); PG8_STAGE(PG8_SB(1, 0), b3, voffB); PG8_STAGE(PG8_SB(1, 1), b3 + hstepB, voffB); PG8_STAGE(PG8_SA(1, 0), a3, voffA);
            PG8_WAIT_V(8); PG8_WAIT_L(0); PG8_BAR; PG8_MMA(1, 0, At, B0); PG8_MMA(1, 1, At, B1); PG8_BAR; PG8_SCHED;
        }
        if (wr == 0) PG8_BAR;
        E(acc, cur, wr, wc, fr, fq);
        if (!has_next) break;
#pragma unroll
        for (int a = 0; a < 2; ++a)
#pragma unroll
            for (int b = 0; b < 2; ++b)
#pragma unroll
                for (int m = 0; m < 4; ++m)
#pragma unroll
                    for (int n = 0; n < 2; ++n) acc[a][b][m][n] = (f32x4){0.f, 0.f, 0.f, 0.f};
        cur = nxt; cA = nA; cB = nB; ++ui;
        if (wr == 1) PG8_BAR;
    }
    PG8_WAIT_V(0);
    PG8_BAR;
#undef PG8_SA
#undef PG8_SB
#undef PG8_STAGE
#undef PG8_LDA
#undef PG8_LDB
#undef PG8_MMA
#undef PG8_WAIT_V
#undef PG8_WAIT_L
#undef PG8_BAR
#undef PG8_SCHED
}

typedef const f32x4 (&AccRef)[2][2][4][2];

struct EpiStore {
    float* F; bf16_t* Bo; int ld; int split_cols; size_t split_stride; float scale; const float* colscale;
    __device__ __forceinline__ void operator()(AccRef acc, const Unit& u, int wr, int wc, int fr, int fq) const {
        int colt = u.col0; size_t soff = 0;
        if (split_cols) { const int t = colt / split_cols; soff = (size_t)t * split_stride; colt -= t * split_cols; }
        const int col0 = colt + wc * 32 + 8 * fq, row0 = u.row0 + wr * 64 + fr;
        f32x4 cs[2][2];
#pragma unroll
        for (int bj = 0; bj < 2; ++bj)
#pragma unroll
            for (int n = 0; n < 2; ++n) { cs[bj][n] = colscale ? *(const f32x4*)(colscale + col0 + bj * HALF + 4 * n) : (f32x4){1.f, 1.f, 1.f, 1.f}; cs[bj][n] = cs[bj][n] * scale; }
#pragma unroll
        for (int ai = 0; ai < 2; ++ai)
#pragma unroll
            for (int m = 0; m < 4; ++m) {
                const size_t off = soff + (size_t)(row0 + ai * HALF + m * 16) * ld + col0;
#pragma unroll
                for (int bj = 0; bj < 2; ++bj) {
                    const f32x4 v0 = acc[ai][bj][m][0] * cs[bj][0], v1 = acc[ai][bj][m][1] * cs[bj][1];
                    if (F) { *(f32x4*)(F + off + bj * HALF) = v0; *(f32x4*)(F + off + bj * HALF + 4) = v1; }
                    if (Bo) { u32x4 w; w.x = pk2(v0[0], v0[1]); w.y = pk2(v0[2], v0[3]); w.z = pk2(v1[0], v1[1]); w.w = pk2(v1[2], v1[3]); *(u32x4*)(Bo + off + bj * HALF) = w; }
                }
            }
    }
};

struct EpiGlu {
    const bf16_t* Z; const float* bias; bf16_t* O;
    __device__ __forceinline__ void operator()(AccRef acc, const Unit& u, int wr, int wc, int fr, int fq) const {
        const int col0 = u.col0 + wc * 32 + 8 * fq, row0 = u.row0 + wr * 64 + fr;
        f32x4 bv[2][2];
#pragma unroll
        for (int bj = 0; bj < 2; ++bj)
#pragma unroll
            for (int n = 0; n < 2; ++n) bv[bj][n] = *(const f32x4*)(bias + col0 + bj * HALF + 4 * n);
#pragma unroll
        for (int ai = 0; ai < 2; ++ai)
#pragma unroll
            for (int m = 0; m < 4; ++m) {
                const size_t row = (size_t)(row0 + ai * HALF + m * 16);
#pragma unroll
                for (int bj = 0; bj < 2; ++bj) {
                    const u32x4 zz = *(const u32x4*)(Z + row * DSSM + col0 + bj * HALF);
                    const f32x4 a0 = acc[ai][bj][m][0] + bv[bj][0], a1 = acc[ai][bj][m][1] + bv[bj][1];
                    float o[8];
#pragma unroll
                    for (int e = 0; e < 8; ++e) {
                        const unsigned zw = (e < 2) ? zz.x : (e < 4) ? zz.y : (e < 6) ? zz.z : zz.w;
                        const float zf = (e & 1) ? bf2f(zw >> 16) : bf2f(zw & 0xffffu);
                        const float av = (e < 4) ? a0[e & 3] : a1[e & 3];
                        o[e] = zf / (1.f + __expf(-av));
                    }
                    u32x4 w; w.x = pk2(o[0], o[1]); w.y = pk2(o[2], o[3]); w.z = pk2(o[4], o[5]); w.w = pk2(o[6], o[7]);
                    *(u32x4*)(O + row * DM + DPOOL + col0 + bj * HALF) = w;
                }
            }
    }
};

struct EpiResid {
    const float* res0; const float* res1; float* O;
    __device__ __forceinline__ void operator()(AccRef acc, const Unit& u, int wr, int wc, int fr, int fq) const {
        const int col0 = u.col0 + wc * 32 + 8 * fq, row0 = u.row0 + wr * 64 + fr;
        const float* rb = (u.row0 < MP) ? res0 : (res1 - (size_t)MP * DM);
#pragma unroll
        for (int ai = 0; ai < 2; ++ai)
#pragma unroll
            for (int m = 0; m < 4; ++m) {
                const size_t off = (size_t)(row0 + ai * HALF + m * 16) * DM + col0;
#pragma unroll
                for (int bj = 0; bj < 2; ++bj) {
                    const f32x4 r0 = *(const f32x4*)(rb + off + bj * HALF), r1 = *(const f32x4*)(rb + off + bj * HALF + 4);
                    *(f32x4*)(O + off + bj * HALF) = r0 * ALPHA + acc[ai][bj][m][0];
                    *(f32x4*)(O + off + bj * HALF + 4) = r1 * ALPHA + acc[ai][bj][m][1];
                }
                if (m & 1) asm volatile("" ::: "memory");
            }
    }
};

struct EpiGateUp {
    bf16_t* O; float* pconv; float* sconv;
    __device__ __forceinline__ void operator()(AccRef acc, const Unit& u, int wr, int wc, int fr, int fq) const {
        const int col0 = u.col0 + wc * 32 + 8 * fq, row0 = u.row0 + wr * 64 + fr;
        const bool gate = u.col0 < DFF;
#pragma unroll
        for (int ai = 0; ai < 2; ++ai)
#pragma unroll
            for (int m = 0; m < 4; ++m) {
                const int row = row0 + ai * HALF + m * 16;
                const size_t off = (size_t)row * (2 * DFF) + col0;
                float* st = nullptr;
                if (gate) {
                    if (row < MP) { const int t = row & (SEQ - 1); if (t >= SEQ - 2) st = pconv + ((size_t)(row >> 11) * 2 + (t - (SEQ - 2))) * DFF; }
                    else { const int r = row - MP, t = r & 3; if (t >= 2) st = sconv + ((size_t)(r >> 2) * 2 + (t - 2)) * DFF; }
                }
#pragma unroll
                for (int bj = 0; bj < 2; ++bj) {
                    const f32x4 v0 = acc[ai][bj][m][0], v1 = acc[ai][bj][m][1];
                    u32x4 w; w.x = pk2(v0[0], v0[1]); w.y = pk2(v0[2], v0[3]); w.z = pk2(v1[0], v1[1]); w.w = pk2(v1[2], v1[3]);
                    *(u32x4*)(O + off + bj * HALF) = w;
                    if (st) { *(f32x4*)(st + col0 + bj * HALF) = v0; *(f32x4*)(st + col0 + bj * HALF + 4) = v1; }
                }
            }
    }
};

struct SchedS {
    const char* Q; const char* Kb; int G, c;
    __device__ __forceinline__ bool next(int i, Unit& u) const {
        const int L = i * G + c; if (L >= 128) return false;
        const int z = L >> 3, pm = L & 7, b = z >> 2, h = z & 3;
        u.a = Q + ((size_t)(b * SEQ + pm * 256) * DM + h * HD) * 2; u.b = Kb + ((size_t)(b * NMEM) * DM + h * HD) * 2;
        u.row0 = z * SEQ + pm * 256; u.col0 = 0; return true;
    }
};
struct SchedPV {
    const char* P; const char* Vt; int G, c;
    __device__ __forceinline__ bool next(int i, Unit& u) const {
        const int L = i * G + c; if (L >= 256) return false;
        const int pn = L & 1, pm = (L >> 1) & 7, z = L >> 4, b = z >> 2, h = z & 3;
        u.a = P + ((size_t)(z * SEQ + pm * 256) * NMEM) * 2; u.b = Vt + ((size_t)(h * HD + pn * 256) * (NB * NMEM) + b * NMEM) * 2;
        u.row0 = b * SEQ + pm * 256; u.col0 = h * HD + pn * 256; return true;
    }
};
}

#define XB_TMO      128
#define XB_XCNT(j)  (256  + 64 * (j))
#define XB_XSUB(j)  (1280 + 64 * (j))
#define XB_XGEN(j)  (2304 + 64 * (j))
#define XB_TOP      3328
#define XB_TOPGEN   3392
#define XCD_BAR_WORDS 3456
#define XB_SPIN_CAP (1u << 18)

__device__ __forceinline__ unsigned xb_ld(unsigned* p)              { return __hip_atomic_load(p, __ATOMIC_RELAXED, __HIP_MEMORY_SCOPE_AGENT); }
__device__ __forceinline__ unsigned xb_add(unsigned* p, unsigned v) { return __hip_atomic_fetch_add(p, v, __ATOMIC_RELAXED, __HIP_MEMORY_SCOPE_AGENT); }
__device__ __forceinline__ unsigned xb_xcc_id() { return (unsigned)__builtin_amdgcn_s_getreg((3 << 11) | 20) & 0xFu; }
#define XB_SPIN(cond, bar) do { unsigned _sp = 0; while (cond) { __builtin_amdgcn_s_sleep(1); \
    if ((++_sp & 255u) == 0u) { if (xb_ld(&(bar)[XB_TMO])) break; if (_sp > XB_SPIN_CAP) { atomicAdd(&(bar)[XB_TMO], 1u); break; } } } } while (0)

struct XcdBarrier {
    unsigned* bar; unsigned x;
    volatile LAS unsigned* st;
};

__device__ __forceinline__ XcdBarrier xcd_barrier_post(unsigned* bar, volatile LAS unsigned* st) {
    XcdBarrier b; b.bar = bar; b.x = xb_xcc_id(); b.st = st;
    if (threadIdx.x == 0) (void)xb_add(&bar[XB_XCNT(b.x)], 1u);
    return b;
}
__device__ __forceinline__ void xcd_barrier_complete(unsigned* bar, unsigned x, unsigned& nloc, unsigned& nx) {
    const unsigned G = gridDim.x * gridDim.y * gridDim.z;
    unsigned sum, cnt, mine, sp = 0u;
    for (;;) {
        sum = 0u; cnt = 0u; mine = 0u;
#pragma unroll
        for (unsigned j = 0; j < 16; ++j) { const unsigned c = xb_ld(&bar[XB_XCNT(j)]); sum += c; cnt += (c > 0u) ? 1u : 0u; mine = (j == x) ? c : mine; }
        if (sum == G) break;
        __builtin_amdgcn_s_sleep(1);
        if ((++sp & 255u) == 0u) { if (xb_ld(&bar[XB_TMO])) break; if (sp > XB_SPIN_CAP) { atomicAdd(&bar[XB_TMO], 1u); break; } }
    }
    nloc = mine > 0u ? mine : 1u; nx = cnt > 0u ? cnt : 1u;
}

__device__ __forceinline__ void xcd_barrier(const XcdBarrier& b) {
    asm volatile("s_waitcnt vmcnt(0)" ::: "memory");
    __syncthreads();
    if (threadIdx.x == 0) {
        unsigned* bar = b.bar;
        __builtin_amdgcn_s_waitcnt(0);
        unsigned nloc = b.st[0], nx = b.st[1];
        if (nloc == 0u) { xcd_barrier_complete(bar, b.x, nloc, nx); b.st[0] = nloc; b.st[1] = nx; }
        const unsigned old = xb_add(&bar[XB_XSUB(b.x)], 1u);
        const unsigned gen = old / nloc;
        if (old + 1u == (gen + 1u) * nloc) {
            __builtin_amdgcn_fence(__ATOMIC_RELEASE, "agent");
            asm volatile("s_waitcnt vmcnt(0)" ::: "memory");
            const unsigned og = xb_add(&bar[XB_TOP], 1u);
            const unsigned tg = og / nx;
            if (og + 1u == (tg + 1u) * nx) xb_add(&bar[XB_TOPGEN], 1u);
            else XB_SPIN(xb_ld(&bar[XB_TOPGEN]) == tg, bar);
            __builtin_amdgcn_fence(__ATOMIC_ACQUIRE, "agent");
            xb_add(&bar[XB_XGEN(b.x)], 1u);
            asm volatile("s_waitcnt vmcnt(0)" ::: "memory");
        } else {
            XB_SPIN(xb_ld(&bar[XB_XGEN(b.x)]) == gen, bar);
            __builtin_amdgcn_fence(__ATOMIC_ACQUIRE, "agent");
            asm volatile("s_waitcnt vmcnt(0)" ::: "memory");
        }
    }
    __syncthreads();
}


constexpr int SK_LD = 68;
template <class Epi>
__device__ __forceinline__ void skinny_gemm(LAS unsigned char* lds, const bf16_t* A, int lda, const bf16_t* Bt, int ldb, int K, const Epi& E) {
    const int tid = threadIdx.x, lane = lane_id(), wave = wave_id(), l16 = lane & 15, q = lane >> 4;
    LAS float* red = (LAS float*)lds;
    const int ks = K / 8;
    for (int p = blockIdx.x; p < 256; p += gridDim.x) {
        const int rb = p & 7, cb = p >> 3;
        f32x4 acc[4][4];
#pragma unroll
        for (int i = 0; i < 4; ++i)
#pragma unroll
            for (int j = 0; j < 4; ++j) acc[i][j] = (f32x4){0.f, 0.f, 0.f, 0.f};
        const bf16_t* ap = A + (size_t)(rb * 64 + l16) * lda + wave * ks + 8 * q;
        const bf16_t* bp = Bt + (size_t)(cb * 64 + l16) * ldb + wave * ks + 8 * q;
#pragma unroll 4
        for (int k = 0; k < ks; k += 32) {
            bf16x8 af[4], bfr[4];
#pragma unroll
            for (int i = 0; i < 4; ++i) af[i] = *(const bf16x8*)(ap + (size_t)(16 * i) * lda + k);
#pragma unroll
            for (int j = 0; j < 4; ++j) bfr[j] = *(const bf16x8*)(bp + (size_t)(16 * j) * ldb + k);
#pragma unroll
            for (int i = 0; i < 4; ++i)
#pragma unroll
                for (int j = 0; j < 4; ++j) acc[i][j] = __builtin_amdgcn_mfma_f32_16x16x32_bf16(bfr[j], af[i], acc[i][j], 0, 0, 0);
        }
#pragma unroll
        for (int i = 0; i < 4; ++i)
#pragma unroll
            for (int j = 0; j < 4; ++j) *(LAS f32x4*)(red + (wave * 64 + 16 * i + l16) * SK_LD + 16 * j + 4 * q) = acc[i][j];
        __syncthreads();
        {
            const int r = tid >> 3, c8 = (tid & 7) * 8;
            f32x4 s0 = (f32x4){0.f, 0.f, 0.f, 0.f}, s1 = (f32x4){0.f, 0.f, 0.f, 0.f};
#pragma unroll
            for (int w = 0; w < 8; ++w) { s0 += *(LAS f32x4*)(red + (w * 64 + r) * SK_LD + c8); s1 += *(LAS f32x4*)(red + (w * 64 + r) * SK_LD + c8 + 4); }
            E(s0, s1, rb * 64 + r, cb * 64 + c8);
        }
        __syncthreads();
    }
}
struct SkStore {
    float* F; bf16_t* Bo; float scale;
    __device__ __forceinline__ void operator()(f32x4 v0, f32x4 v1, int row, int col) const {
        v0 = v0 * scale; v1 = v1 * scale;
        if (F) { *(f32x4*)(F + (size_t)row * DM + col) = v0; *(f32x4*)(F + (size_t)row * DM + col + 4) = v1; }
        if (Bo) { u32x4 w; w.x = pk2(v0[0], v0[1]); w.y = pk2(v0[2], v0[3]); w.z = pk2(v1[0], v1[1]); w.w = pk2(v1[2], v1[3]); *(u32x4*)(Bo + (size_t)row * DM + col) = w; }
    }
};
struct SkResid {
    const float* res; float* O;
    __device__ __forceinline__ void operator()(f32x4 v0, f32x4 v1, int row, int col) const {
        const size_t off = (size_t)row * DM + col;
        const f32x4 r0 = *(const f32x4*)(res + off), r1 = *(const f32x4*)(res + off + 4);
        *(f32x4*)(O + off) = r0 * ALPHA + v0; *(f32x4*)(O + off + 4) = r1 * ALPHA + v1;
    }
};

struct Args { const float* in[38]; float* out; unsigned char* ws; int ph_lo, ph_hi; };
#define CAS __attribute__((address_space(4)))
typedef const CAS Args* ArgP;
__device__ __forceinline__ ArgP argp() { ArgP p = (ArgP)__builtin_amdgcn_kernarg_segment_ptr(); asm volatile("" : "+s"(p)); return p; }

__device__ __forceinline__ void transpose_item(const float* W, int K, int N, bf16_t* WT, int row_off, LAS float* scr, int item, int lane) {
    const int nblk = N / 32, kb = item / nblk, nb = item % nblk, k0 = 64 * kb, n0 = 32 * nb;
#pragma unroll 8
    for (int i = 0; i < 32; ++i) { const int kk = 2 * i + (lane >> 5); scr[kk * 33 + (lane & 31)] = W[(size_t)(k0 + kk) * N + n0 + (lane & 31)]; }
    asm volatile("s_waitcnt lgkmcnt(0)" ::: "memory");
    const int c = lane & 7;
#pragma unroll
    for (int j = 0; j < 4; ++j) { const int n = (lane >> 3) + 8 * j; const LAS float* s = scr + (8 * c) * 33 + n;
        u32x4 o; o.x = pk2(s[0 * 33], s[1 * 33]); o.y = pk2(s[2 * 33], s[3 * 33]); o.z = pk2(s[4 * 33], s[5 * 33]); o.w = pk2(s[6 * 33], s[7 * 33]);
        *(u32x4*)(WT + (size_t)(row_off + n0 + n) * K + k0 + 8 * c) = o; }
    asm volatile("s_waitcnt lgkmcnt(0)" ::: "memory");
}

__device__ __forceinline__ void cvt_rows(const float* src, bf16_t* dst, size_t n8, size_t gtid, size_t nthr) {
    for (size_t i = gtid; i < n8; i += nthr) {
        const f32x4 a = *(const f32x4*)(src + i * 8), b = *(const f32x4*)(src + i * 8 + 4);
        u32x4 w; w.x = pk2(a[0], a[1]); w.y = pk2(a[2], a[3]); w.z = pk2(b[0], b[1]); w.w = pk2(b[2], b[3]);
        *(u32x4*)(dst + i * 8) = w;
    }
}

__device__ __forceinline__ void phase_prep(LAS unsigned char* lds) {
    const int lane = lane_id(), wave = wave_id();
    ArgP A = argp(); unsigned char* ws = A->ws;
    const int G = gridDim.x, gw = blockIdx.x * 8 + wave, NGW = G * 8;
    LAS float* scr = (LAS float*)(lds + wave * 16384);
    constexpr int I_SQ = 2048, I_POOL = 32, I_GLU = 512, I_FF = 5632;
    constexpr int NITEMS = 3 * I_FF + 6 * I_SQ + I_GLU + 4 * I_POOL;
    for (int it = gw; it < NITEMS; it += NGW) {
        int r = it;
        if (r < I_FF) { transpose_item(A->in[31], DM, DFF, (bf16_t*)(ws + WS_WGU), 0, scr, r, lane); continue; } r -= I_FF;
        if (r < I_FF) { transpose_item(A->in[32], DM, DFF, (bf16_t*)(ws + WS_WGU), DFF, scr, r, lane); continue; } r -= I_FF;
        if (r < I_FF) { transpose_item(A->in[35], DFF, DM, (bf16_t*)(ws + WS_WDOWN), 0, scr, r, lane); continue; } r -= I_FF;
        if (r < I_SQ) { transpose_item(A->in[9], DM, DM, (bf16_t*)(ws + WS_WIN), 0, scr, r, lane); continue; } r -= I_SQ;
        if (r < I_SQ) { transpose_item(A->in[26], DM, DM, (bf16_t*)(ws + WS_WKV), 0, scr, r, lane); continue; } r -= I_SQ;
        if (r < I_SQ) { transpose_item(A->in[27], DM, DM, (bf16_t*)(ws + WS_WKV), DM, scr, r, lane); continue; } r -= I_SQ;
        if (r < I_SQ) { transpose_item(A->in[22], DM, DM, (bf16_t*)(ws + WS_WOUT), 0, scr, r, lane); continue; } r -= I_SQ;
        if (r < I_SQ) { transpose_item(A->in[25], DM, DM, (bf16_t*)(ws + WS_WQ), 0, scr, r, lane); continue; } r -= I_SQ;
        if (r < I_SQ) { transpose_item(A->in[28], DM, DM, (bf16_t*)(ws + WS_WO), 0, scr, r, lane); continue; } r -= I_SQ;
        if (r < I_GLU) { transpose_item(A->in[20], DSSM, DSSM, (bf16_t*)(ws + WS_WGLU), 0, scr, r, lane); continue; } r -= I_GLU;
        { const int g = r / I_POOL; transpose_item(A->in[10] + (size_t)g * 65536, 256, 256, (bf16_t*)(ws + WS_WPOOL) + (size_t)g * 65536, 0, scr, r % I_POOL, lane); }
    }
    const size_t gtid = (size_t)blockIdx.x * 512 + threadIdx.x, nthr = (size_t)G * 512;
    cvt_rows(A->in[0], (bf16_t*)(ws + WS_XB), (size_t)MP * DM / 8, gtid, nthr);
    cvt_rows(A->in[1], (bf16_t*)(ws + WS_XB) + (size_t)MP * DM, (size_t)MS * DM / 8, gtid, nthr);
    cvt_rows(A->in[2], (bf16_t*)(ws + WS_MEMB), (size_t)NB * NMEM * DM / 8, gtid, nthr);
    const float* lre = A->in[12]; const float* lim = A->in[13]; const float* lstep = A->in[14];
    const float* bre = A->in[15]; const float* bim = A->in[16]; const float* cre = A->in[17]; const float* cim = A->in[18];
    unsigned char* st = ws + WS_SSMT;
    for (size_t i = gtid; i < (size_t)NG * NST; i += nthr) {
        const int g = (int)(i >> 6), n = (int)(i & 63);
        const float dt = expf(lstep[g]);
        const float ar = lre[i], ai = lim[i];
        const float er = expf(ar * dt); float sn, cs; sincosf(ai * dt, &sn, &cs);
        const float br = er * cs, bi = er * sn;
        ((float*)(st + ST_LAM))[2 * i] = br; ((float*)(st + ST_LAM))[2 * i + 1] = bi;
        const float nr = br - 1.f, ni = bi, den = ar * ar + ai * ai;
        const float fr_ = (nr * ar + ni * ai) / den, fi_ = (ni * ar - nr * ai) / den;
        float pr[16], pi[16];
#pragma unroll
        for (int c = 0; c < 16; ++c) { const float x = bre[i * 16 + c], y = bim[i * 16 + c]; pr[c] = fr_ * x - fi_ * y; pi[c] = fr_ * y + fi_ * x; }
        u32x4* bop = (u32x4*)(st + ST_BOP) + (size_t)g * 8 * 64;
        const int blk = n >> 4, l16 = n & 15;
        u32x4 w;
        w.x = pk2(pr[0], pr[1]); w.y = pk2(pr[2], pr[3]); w.z = pk2(pr[4], pr[5]); w.w = pk2(pr[6], pr[7]); bop[(blk) * 64 + 0 * 16 + l16] = w;
        w.x = pk2(pr[8], pr[9]); w.y = pk2(pr[10], pr[11]); w.z = pk2(pr[12], pr[13]); w.w = pk2(pr[14], pr[15]); bop[(blk) * 64 + 1 * 16 + l16] = w;
        w.x = pk2(pi[0], pi[1]); w.y = pk2(pi[2], pi[3]); w.z = pk2(pi[4], pi[5]); w.w = pk2(pi[6], pi[7]); bop[(4 + blk) * 64 + 0 * 16 + l16] = w;
        w.x = pk2(pi[8], pi[9]); w.y = pk2(pi[10], pi[11]); w.z = pk2(pi[12], pi[13]); w.w = pk2(pi[14], pi[15]); bop[(4 + blk) * 64 + 1 * 16 + l16] = w;
        const u32x4 zz = (u32x4){0u, 0u, 0u, 0u};
        bop[(blk) * 64 + 2 * 16 + l16] = zz; bop[(blk) * 64 + 3 * 16 + l16] = zz; bop[(4 + blk) * 64 + 2 * 16 + l16] = zz; bop[(4 + blk) * 64 + 3 * 16 + l16] = zz;
    }
    for (size_t i = gtid; i < (size_t)NG * 4 * 64; i += nthr) {
        const int L = (int)(i & 63), kk = (int)((i >> 6) & 3), g = (int)(i >> 8);
        const int c = L & 15, q = L >> 4, k0 = 32 * kk + 8 * q;
        float v[8];
#pragma unroll
        for (int e = 0; e < 8; ++e) { const int k = k0 + e; v[e] = (k < 64) ? cre[((size_t)g * 16 + c) * 64 + k] : -cim[((size_t)g * 16 + c) * 64 + (k - 64)]; }
        u32x4 w; w.x = pk2(v[0], v[1]); w.y = pk2(v[2], v[3]); w.z = pk2(v[4], v[5]); w.w = pk2(v[6], v[7]);
        ((u32x4*)(st + ST_COP))[i] = w;
    }
}

__device__ __forceinline__ void phase_pool() {
    ArgP A = argp(); unsigned char* ws = A->ws; const float* U = (const float*)(ws + WS_U); bf16_t* PO = (bf16_t*)(ws + WS_POOLED);
    const size_t gtid = (size_t)blockIdx.x * 512 + threadIdx.x, nthr = (size_t)gridDim.x * 512;
    for (size_t it = gtid; it < (size_t)(MP / 16) * 256; it += nthr) {
        const int qd = (int)(it & 255), tb = (int)(it >> 8), ch = qd * 4, w = 2 << (ch >> 8);
        const int row0 = tb * 16, t0 = row0 & (SEQ - 1);
        const float* up = U + (size_t)row0 * DM + ch;
        f32x4 s = (f32x4){0.f, 0.f, 0.f, 0.f};
        for (int j = 1; j < w; ++j) if (t0 - j >= 0) s += *(const f32x4*)(up - (size_t)j * DM);
        for (int j = 0; j < 16; ++j) {
            const f32x4 x = *(const f32x4*)(up + (size_t)j * DM);
            s += x;
            const int t = t0 + j; const float inv = 1.f / (float)((t + 1 < w) ? (t + 1) : w);
            const f32x4 o = s * inv - x;
            u32x2 pk; pk.x = pk2(o[0], o[1]); pk.y = pk2(o[2], o[3]);
            *(u32x2*)(PO + (size_t)(row0 + j) * DPOOL + ch) = pk;
            if (t - w + 1 >= 0) s -= *(const f32x4*)(up + (size_t)(j - w + 1) * DM);
        }
    }
    const float* SP = A->in[3];
    for (size_t it = gtid; it < (size_t)DB * 256; it += nthr) {
        const int qd = (int)(it & 255), b = (int)(it >> 8), ch = qd * 4, w = 2 << (ch >> 8);
        const float* sp = SP + (size_t)b * PBUF * DPOOL + ch;
        const float* up = U + (size_t)(MP + b * 4) * DM + ch;
        f32x4 s = (f32x4){0.f, 0.f, 0.f, 0.f};
        for (int j = 1; j < w; ++j) s += *(const f32x4*)(sp + (size_t)(PBUF - j) * DPOOL);
        const float inv = 1.f / (float)w;
        for (int j = 0; j < 4; ++j) {
            const f32x4 x = *(const f32x4*)(up + (size_t)j * DM);
            s += x;
            const f32x4 o = s * inv - x;
            u32x2 pk; pk.x = pk2(o[0], o[1]); pk.y = pk2(o[2], o[3]);
            *(u32x2*)(PO + (size_t)(MP + b * 4 + j) * DPOOL + ch) = pk;
            const int e = 15 + j - w + 1;
            s -= (e < PBUF) ? *(const f32x4*)(sp + (size_t)e * DPOOL) : *(const f32x4*)(up + (size_t)(e - PBUF) * DM);
        }
    }
    float* out = A->out;
    for (size_t it = gtid; it < (size_t)NB * PBUF * 256; it += nthr) {
        const int qd = (int)(it & 255), r = (int)(it >> 8), b = r / PBUF, j = r % PBUF;
        *(f32x4*)(out + O_PPOOL + (size_t)r * DPOOL + qd * 4) = *(const f32x4*)(U + (size_t)(b * SEQ + SEQ - PBUF + j) * DM + qd * 4);
    }
    for (size_t it = gtid; it < (size_t)DB * PBUF * 256; it += nthr) {
        const int qd = (int)(it & 255), r = (int)(it >> 8), b = r / PBUF, j = r % PBUF;
        const f32x4 v = (j < PBUF - DT) ? *(const f32x4*)(SP + ((size_t)b * PBUF + j + DT) * DPOOL + qd * 4) : *(const f32x4*)(U + (size_t)(MP + b * 4 + (j - (PBUF - DT))) * DM + qd * 4);
        *(f32x4*)(out + O_SPOOL + (size_t)r * DPOOL + qd * 4) = v;
    }
}

constexpr int BU_LD = 132;
constexpr int HB_LD = 136;
constexpr int SSM_WAVE_LDS = 16 * BU_LD * 4 + 16 * HB_LD * 2;

__device__ __forceinline__ float gelu_tanh(float y) { const float t = 1.5957691216f * (y + 0.044715f * y * y * y); return y / (1.f + __expf(-t)); }

__device__ __forceinline__ void ssm_bu_tile(const float* U, int row0, int g, int lane, const bf16x8 (&Bop)[8], LAS float* bu) {
    const int l16 = lane & 15, q = lane >> 4;
    bf16x8 ub = (bf16x8){0, 0, 0, 0, 0, 0, 0, 0};
    if (q < 2) {
        const float* p = U + (size_t)(row0 + l16) * DM + DPOOL + g * CH + 8 * q;
        const f32x4 a = *(const f32x4*)p, b = *(const f32x4*)(p + 4);
        u32x4 w; w.x = pk2(a[0], a[1]); w.y = pk2(a[2], a[3]); w.z = pk2(b[0], b[1]); w.w = pk2(b[2], b[3]);
        ub = __builtin_bit_cast(bf16x8, w);
    }
#pragma unroll
    for (int blk = 0; blk < 8; ++blk) {
        const f32x4 d = __builtin_amdgcn_mfma_f32_16x16x32_bf16(Bop[blk], ub, (f32x4){0.f, 0.f, 0.f, 0.f}, 0, 0, 0);
        *(LAS f32x4*)(bu + l16 * BU_LD + 16 * blk + 4 * q) = d;
    }
}
__device__ __forceinline__ void ssm_y_tile(const float* U, const float* dskip, bf16_t* Z, int row0, int g, int lane, const bf16x8 (&Cop)[4], const LAS bf16_t* hb) {
    const int l16 = lane & 15, q = lane >> 4;
    f32x4 acc = (f32x4){0.f, 0.f, 0.f, 0.f};
#pragma unroll
    for (int kk = 0; kk < 4; ++kk) {
        const bf16x8 b = *(const LAS bf16x8*)(hb + l16 * HB_LD + 32 * kk + 8 * q);
        acc = __builtin_amdgcn_mfma_f32_16x16x32_bf16(Cop[kk], b, acc, 0, 0, 0);
    }
    const int row = row0 + l16, ch = g * CH + 4 * q;
    const f32x4 uu = *(const f32x4*)(U + (size_t)row * DM + DPOOL + ch), dk = *(const f32x4*)(dskip + ch);
    const f32x4 y = acc + dk * uu;
    u32x2 pk; pk.x = pk2(gelu_tanh(y[0]), gelu_tanh(y[1])); pk.y = pk2(gelu_tanh(y[2]), gelu_tanh(y[3]));
    *(u32x2*)(Z + (size_t)row * DSSM + ch) = pk;
}

__device__ __forceinline__ void phase_ssm(LAS unsigned char* lds) {
    const int lane = lane_id(), wave = wave_id();
    ArgP A = argp(); unsigned char* ws = A->ws; const float* U = (const float*)(ws + WS_U); bf16_t* Z = (bf16_t*)(ws + WS_Z);
    const unsigned char* st = ws + WS_SSMT; const float* dskip = A->in[19]; float* out = A->out;
    LAS float* bu = (LAS float*)(lds + wave * SSM_WAVE_LDS);
    LAS bf16_t* hb = (LAS bf16_t*)(lds + wave * SSM_WAVE_LDS + 16 * BU_LD * 4);
    LAS float* xs = (LAS float*)(lds + 8 * SSM_WAVE_LDS);
    for (int task = blockIdx.x; task < NB * NG; task += gridDim.x) {
        const int b = task >> 6, g = task & 63;
        bf16x8 Bop[8], Cop[4];
#pragma unroll
        for (int i = 0; i < 8; ++i) Bop[i] = *(const bf16x8*)(st + ST_BOP + ((size_t)(g * 8 + i) * 64 + lane) * 16);
#pragma unroll
        for (int i = 0; i < 4; ++i) Cop[i] = *(const bf16x8*)(st + ST_COP + ((size_t)(g * 4 + i) * 64 + lane) * 16);
        const float lr = ((const float*)(st + ST_LAM))[2 * (g * 64 + lane)], li = ((const float*)(st + ST_LAM))[2 * (g * 64 + lane) + 1];
        const int rowb = b * SEQ + wave * 256;
        float hr = 0.f, hi = 0.f;
        for (int tl = 0; tl < 16; ++tl) {
            ssm_bu_tile(U, rowb + tl * 16, g, lane, Bop, bu);
#pragma unroll
            for (int j = 0; j < 16; ++j) { const float br = bu[j * BU_LD + lane], bi = bu[j * BU_LD + 64 + lane];
                const float nr = lr * hr - li * hi + br, ni = lr * hi + li * hr + bi; hr = nr; hi = ni; }
        }
        xs[(wave * 64 + lane) * 2] = hr; xs[(wave * 64 + lane) * 2 + 1] = hi;
        __syncthreads();
        float pr = lr, pi = li;
#pragma unroll
        for (int s = 0; s < 8; ++s) { const float a = pr * pr - pi * pi, c = 2.f * pr * pi; pr = a; pi = c; }
        hr = 0.f; hi = 0.f;
        for (int w2 = 0; w2 < wave; ++w2) { const float sr = xs[(w2 * 64 + lane) * 2], si = xs[(w2 * 64 + lane) * 2 + 1];
            const float nr = pr * hr - pi * hi + sr, ni = pr * hi + pi * hr + si; hr = nr; hi = ni; }
        for (int tl = 0; tl < 16; ++tl) {
            ssm_bu_tile(U, rowb + tl * 16, g, lane, Bop, bu);
#pragma unroll
            for (int j = 0; j < 16; ++j) { const float br = bu[j * BU_LD + lane], bi = bu[j * BU_LD + 64 + lane];
                const float nr = lr * hr - li * hi + br, ni = lr * hi + li * hr + bi; hr = nr; hi = ni;
                hb[j * HB_LD + lane] = (bf16_t)f2bf(hr); hb[j * HB_LD + 64 + lane] = (bf16_t)f2bf(hi); }
            ssm_y_tile(U, dskip, Z, rowb + tl * 16, g, lane, Cop, hb);
        }
        if (wave == 7) { out[O_PRE + (size_t)(b * NG + g) * NST + lane] = hr; out[O_PIM + (size_t)(b * NG + g) * NST + lane] = hi; }
        __syncthreads();
    }
    const float* s0r = A->in[4]; const float* s0i = A->in[5];
    for (int task = blockIdx.x * 8 + wave; task < NG * (DB / 4); task += gridDim.x * 8) {
        const int g = task & 63, bq = task >> 6;
        bf16x8 Bop[8], Cop[4];
#pragma unroll
        for (int i = 0; i < 8; ++i) Bop[i] = *(const bf16x8*)(st + ST_BOP + ((size_t)(g * 8 + i) * 64 + lane) * 16);
#pragma unroll
        for (int i = 0; i < 4; ++i) Cop[i] = *(const bf16x8*)(st + ST_COP + ((size_t)(g * 4 + i) * 64 + lane) * 16);
        const float lr = ((const float*)(st + ST_LAM))[2 * (g * 64 + lane)], li = ((const float*)(st + ST_LAM))[2 * (g * 64 + lane) + 1];
        const int row0 = MP + bq * 16;
        ssm_bu_tile(U, row0, g, lane, Bop, bu);
        float hr = 0.f, hi = 0.f;
#pragma unroll
        for (int j = 0; j < 16; ++j) {
            const int bb = bq * 4 + (j >> 2);
            if ((j & 3) == 0) { hr = s0r[(size_t)(bb * NG + g) * NST + lane]; hi = s0i[(size_t)(bb * NG + g) * NST + lane]; }
            const float br = bu[j * BU_LD + lane], bi = bu[j * BU_LD + 64 + lane];
            const float nr = lr * hr - li * hi + br, ni = lr * hi + li * hr + bi; hr = nr; hi = ni;
            hb[j * HB_LD + lane] = (bf16_t)f2bf(hr); hb[j * HB_LD + 64 + lane] = (bf16_t)f2bf(hi);
            if ((j & 3) == 3) { out[O_SRE + (size_t)(bb * NG + g) * NST + lane] = hr; out[O_SIM + (size_t)(bb * NG + g) * NST + lane] = hi; }
        }
        ssm_y_tile(U, dskip, Z, row0, g, lane, Cop, hb);
    }
}

template <bool FINAL>
__device__ __forceinline__ void phase_ln(const float* X, const float* gam, const float* bet, float* O32, bf16_t* O16) {
    const int lane = lane_id(), wave = wave_id();
    const int gw = blockIdx.x * 8 + wave, NGW = gridDim.x * 8;
    for (int row = gw; row < MT; row += NGW) {
        const f32x4* xr = (const f32x4*)(X + (size_t)row * DM) + lane;
        f32x4 v[8]; float s = 0.f;
#pragma unroll
        for (int j = 0; j < 8; ++j) { v[j] = xr[64 * j]; s += (v[j][0] + v[j][1]) + (v[j][2] + v[j][3]); }
        const float mean = wave_sum(s) * (1.f / DM); float s2 = 0.f;
#pragma unroll
        for (int j = 0; j < 8; ++j) { v[j] = v[j] - mean; s2 += (v[j][0] * v[j][0] + v[j][1] * v[j][1]) + (v[j][2] * v[j][2] + v[j][3] * v[j][3]); }
        const float rstd = 1.f / sqrtf(wave_sum(s2) * (1.f / DM) + LN_EPS);
#pragma unroll
        for (int j = 0; j < 8; ++j) {
            const f32x4 gg = ((const f32x4*)gam)[lane + 64 * j], bb = ((const f32x4*)bet)[lane + 64 * j];
            const f32x4 o = v[j] * rstd * gg + bb;
            ((f32x4*)(O32 + (size_t)row * DM))[lane + 64 * j] = o;
            if (!FINAL) { u32x2 pk; pk.x = pk2(o[0], o[1]); pk.y = pk2(o[2], o[3]); ((u32x2*)(O16 + (size_t)row * DM))[lane + 64 * j] = pk; }
        }
    }
}

__device__ __forceinline__ void phase_softmax(const float* S, bf16_t* P) {
    const int lane = lane_id(), wave = wave_id();
    const int gw = blockIdx.x * 8 + wave, NGW = gridDim.x * 8;
    for (int row = gw; row < NB * NH * SEQ; row += NGW) {
        const f32x4 v = ((const f32x4*)(S + (size_t)row * NMEM))[lane];
        const float mx = wave_max(fmaxf(fmaxf(v[0], v[1]), fmaxf(v[2], v[3])));
        const float e0 = __expf(v[0] - mx), e1 = __expf(v[1] - mx), e2 = __expf(v[2] - mx), e3 = __expf(v[3] - mx);
        const float inv = 1.f / wave_sum((e0 + e1) + (e2 + e3));
        u32x2 pk; pk.x = pk2(e0 * inv, e1 * inv); pk.y = pk2(e2 * inv, e3 * inv);
        ((u32x2*)(P + (size_t)row * NMEM))[lane] = pk;
    }
}

__device__ __forceinline__ void phase_attn_sample(LAS unsigned char* lds) {
    const int lane = lane_id(), wave = wave_id();
    ArgP A = argp();
    const bf16_t* Q = (const bf16_t*)(A->ws + WS_Q); bf16_t* AO = (bf16_t*)(A->ws + WS_AO);
    const float* CK = A->in[7]; const float* CV = A->in[8];
    LAS float* sS = (LAS float*)lds;
    LAS float* sP = (LAS float*)(lds + 4096);
    LAS float* sR = (LAS float*)(lds + 8192);
    const int l16 = lane & 15, q = lane >> 4;
    for (int task = blockIdx.x; task < DB * NH; task += gridDim.x) {
        const int b = task >> 2, h = task & 3;
        f32x4 sacc[2] = {(f32x4){0.f, 0.f, 0.f, 0.f}, (f32x4){0.f, 0.f, 0.f, 0.f}};
        const bf16_t* qrow = Q + (size_t)(MP + b * 4 + (l16 & 3)) * DM + h * HD + 4 * q;
        const float* k0p = CK + ((size_t)(b * NMEM + wave * 32 + l16) * NH + h) * HD + 4 * q;
        const float* k1p = k0p + (size_t)16 * NH * HD;
#pragma unroll 4
        for (int ks = 0; ks < 16; ++ks) {
            u32x2 qa = *(const u32x2*)(qrow + 32 * ks), qb = *(const u32x2*)(qrow + 32 * ks + 16);
            if (l16 >= 4) { qa = (u32x2){0u, 0u}; qb = (u32x2){0u, 0u}; }
            const u32x4 aw = (u32x4){qa.x, qa.y, qb.x, qb.y};
            const f32x4 x0 = __builtin_nontemporal_load((const f32x4*)(k0p + 32 * ks)), x1 = __builtin_nontemporal_load((const f32x4*)(k0p + 32 * ks + 16));
            const f32x4 y0 = __builtin_nontemporal_load((const f32x4*)(k1p + 32 * ks)), y1 = __builtin_nontemporal_load((const f32x4*)(k1p + 32 * ks + 16));
            u32x4 bw0, bw1;
            bw0.x = pk2(x0[0], x0[1]); bw0.y = pk2(x0[2], x0[3]); bw0.z = pk2(x1[0], x1[1]); bw0.w = pk2(x1[2], x1[3]);
            bw1.x = pk2(y0[0], y0[1]); bw1.y = pk2(y0[2], y0[3]); bw1.z = pk2(y1[0], y1[1]); bw1.w = pk2(y1[2], y1[3]);
            sacc[0] = __builtin_amdgcn_mfma_f32_16x16x32_bf16(__builtin_bit_cast(bf16x8, aw), __builtin_bit_cast(bf16x8, bw0), sacc[0], 0, 0, 0);
            sacc[1] = __builtin_amdgcn_mfma_f32_16x16x32_bf16(__builtin_bit_cast(bf16x8, aw), __builtin_bit_cast(bf16x8, bw1), sacc[1], 0, 0, 0);
        }
        if (q == 0) {
#pragma unroll
            for (int t = 0; t < 4; ++t) { sS[t * 256 + wave * 32 + l16] = sacc[0][t]; sS[t * 256 + wave * 32 + 16 + l16] = sacc[1][t]; }
        }
        __syncthreads();
        if (wave < 4) {
            const f32x4 v = *(LAS f32x4*)(sS + wave * 256 + 4 * lane);
            const float mx = wave_max(fmaxf(fmaxf(v[0], v[1]), fmaxf(v[2], v[3])));
            const float e0 = __expf(v[0] - mx), e1 = __expf(v[1] - mx), e2 = __expf(v[2] - mx), e3 = __expf(v[3] - mx);
            const float inv = 1.f / wave_sum((e0 + e1) + (e2 + e3));
            sP[(4 * lane + 0) * 4 + wave] = e0 * inv; sP[(4 * lane + 1) * 4 + wave] = e1 * inv; sP[(4 * lane + 2) * 4 + wave] = e2 * inv; sP[(4 * lane + 3) * 4 + wave] = e3 * inv;
        }
        __syncthreads();
        f32x4 o0[4], o1[4];
#pragma unroll
        for (int t = 0; t < 4; ++t) { o0[t] = (f32x4){0.f, 0.f, 0.f, 0.f}; o1[t] = (f32x4){0.f, 0.f, 0.f, 0.f}; }
        const float* vp = CV + ((size_t)(b * NMEM + wave * 32) * NH + h) * HD + 4 * lane;
#pragma unroll 8
        for (int kx = 0; kx < 32; ++kx) {
            const f32x4 v0 = __builtin_nontemporal_load((const f32x4*)(vp + (size_t)kx * NH * HD)), v1 = __builtin_nontemporal_load((const f32x4*)(vp + (size_t)kx * NH * HD + 256));
            const f32x4 p = *(LAS f32x4*)(sP + (wave * 32 + kx) * 4);
#pragma unroll
            for (int t = 0; t < 4; ++t) { o0[t] += v0 * p[t]; o1[t] += v1 * p[t]; }
        }
#pragma unroll
        for (int t = 0; t < 4; ++t) { *(LAS f32x4*)(sR + (wave * 4 + t) * 512 + 4 * lane) = o0[t]; *(LAS f32x4*)(sR + (wave * 4 + t) * 512 + 256 + 4 * lane) = o1[t]; }
        __syncthreads();
        {
            const int t = threadIdx.x >> 7, d4 = (threadIdx.x & 127) * 4;
            f32x4 s = (f32x4){0.f, 0.f, 0.f, 0.f};
#pragma unroll
            for (int w2 = 0; w2 < 8; ++w2) s += *(LAS f32x4*)(sR + (w2 * 4 + t) * 512 + d4);
            u32x2 pk; pk.x = pk2(s[0], s[1]); pk.y = pk2(s[2], s[3]);
            *(u32x2*)(AO + (size_t)(MP + b * 4 + t) * DM + h * HD + d4) = pk;
        }
        __syncthreads();
    }
}

__device__ __forceinline__ void unpack8(const u32x4 w, float (&o)[8]) {
    o[0] = bf2f(w.x & 0xffffu); o[1] = bf2f(w.x >> 16); o[2] = bf2f(w.y & 0xffffu); o[3] = bf2f(w.y >> 16); o[4] = bf2f(w.z & 0xffffu); o[5] = bf2f(w.z >> 16); o[6] = bf2f(w.w & 0xffffu); o[7] = bf2f(w.w >> 16);
}
__device__ __forceinline__ void phase_act() {
    ArgP A = argp();
    const bf16_t* GU = (const bf16_t*)(A->ws + WS_GU); bf16_t* ACT = (bf16_t*)(A->ws + WS_ACT);
    const float* cw = A->in[33]; const float* cb = A->in[34]; const float* sc = A->in[6];
    const int gtid = blockIdx.x * 512 + threadIdx.x, nthr = gridDim.x * 512;
    constexpr int FG = DFF / 8, RC = 16;
    for (int it = gtid; it < (MT / RC) * FG; it += nthr) {
        const int fg = it % FG, row0 = (it / FG) * RC, f0 = fg * 8;
        float w0[8], w1[8], w2[8], bb[8];
#pragma unroll
        for (int e = 0; e < 8; e += 4) {
            const f32x4 a = *(const f32x4*)(cw + f0 + e), b = *(const f32x4*)(cw + DFF + f0 + e), c = *(const f32x4*)(cw + 2 * DFF + f0 + e), d = *(const f32x4*)(cb + f0 + e);
#pragma unroll
            for (int k = 0; k < 4; ++k) { w0[e + k] = a[k]; w1[e + k] = b[k]; w2[e + k] = c[k]; bb[e + k] = d[k]; }
        }
        const bool samp = row0 >= MP;
        float g0[8], g1[8];
#pragma unroll
        for (int e = 0; e < 8; ++e) { g0[e] = 0.f; g1[e] = 0.f; }
        if (!samp && (row0 & (SEQ - 1)) != 0) {
            unpack8(*(const u32x4*)(GU + (size_t)(row0 - 2) * (2 * DFF) + f0), g0);
            unpack8(*(const u32x4*)(GU + (size_t)(row0 - 1) * (2 * DFF) + f0), g1);
        }
        const bf16_t* gp = GU + (size_t)row0 * (2 * DFF) + f0;
        bf16_t* op = ACT + (size_t)row0 * DFF + f0;
#pragma unroll 4
        for (int j = 0; j < RC; ++j) {
            if (samp && (j & 3) == 0) {
                const float* p = sc + (size_t)((row0 - MP + j) >> 2) * 2 * DFF + f0;
                const f32x4 a = *(const f32x4*)p, b = *(const f32x4*)(p + 4), c = *(const f32x4*)(p + DFF), d = *(const f32x4*)(p + DFF + 4);
#pragma unroll
                for (int k = 0; k < 4; ++k) { g0[k] = a[k]; g0[4 + k] = b[k]; g1[k] = c[k]; g1[4 + k] = d[k]; }
            }
            float g2[8], up[8], o[8];
            unpack8(*(const u32x4*)(gp + (size_t)j * (2 * DFF)), g2);
            unpack8(*(const u32x4*)(gp + (size_t)j * (2 * DFF) + DFF), up);
#pragma unroll
            for (int e = 0; e < 8; ++e) {
                const float gc = bb[e] + g0[e] * w0[e] + g1[e] * w1[e] + g2[e] * w2[e];
                o[e] = gc * __builtin_amdgcn_rcpf(1.f + __expf(-gc)) * up[e];
                g0[e] = g1[e]; g1[e] = g2[e];
            }
            u32x4 w; w.x = pk2(o[0], o[1]); w.y = pk2(o[2], o[3]); w.z = pk2(o[4], o[5]); w.w = pk2(o[6], o[7]);
            *(u32x4*)(op + (size_t)j * DFF) = w;
        }
    }
}

constexpr int N_PHASES = 16;
__global__ void __launch_bounds__(512, 2) fwd_megakernel(Args args) {
    extern __shared__ __attribute__((aligned(16))) unsigned char lds_raw[];
    LAS unsigned char* lds = (LAS unsigned char*)lds_raw;
    const int G = gridDim.x, c0 = blockIdx.x;
    unsigned char* const ws = argp()->ws;
    const int lo = argp()->ph_lo, hi = argp()->ph_hi;
#define out (argp()->out)
    cg::grid_group grid = cg::this_grid();
    if (threadIdx.x < 4) ((LAS unsigned*)(lds + LDS_BYTES - 16))[threadIdx.x] = 0u;
    __syncthreads();
    XcdBarrier bar = xcd_barrier_post((unsigned*)ws, (volatile LAS unsigned*)(lds + LDS_BYTES - 16));
    if (hi > N_PHASES) grid.sync();
#define IN(k) (lo <= (k) && (k) < hi)
#define SEAM(k) do { if (IN(k) && IN((k) + 1)) xcd_barrier(bar); } while (0)
    using namespace pg8;
    const bf16_t* XB = (const bf16_t*)(ws + WS_XB);

    if (IN(0)) { phase_prep(lds); }
    SEAM(0);
    if (IN(1)) {
        {
            GridSched S{(const char*)XB, (const char*)(ws + WS_WIN), (long)256 * DM * 2, 0, (long)256 * DM * 2, MP / 256, DM / 256, (MP / 256) * (DM / 256), G, c0};
            EpiStore E{(float*)(ws + WS_U), nullptr, DM, 0, 0, 1.f, nullptr};
            gemm_phase(lds, Dims{DM, DM, DM}, S, E);
        }
        skinny_gemm(lds, XB + (size_t)MP * DM, DM, (const bf16_t*)(ws + WS_WIN), DM, DM, SkStore{(float*)(ws + WS_U) + (size_t)MP * DM, nullptr, 1.f});
    }
    SEAM(1);
    if (IN(2)) { phase_pool(); phase_ssm(lds); }
    SEAM(2);
    if (IN(3)) {
        {
            GridSched S{(const char*)(ws + WS_MEMB), (const char*)(ws + WS_WKV), (long)256 * DM * 2, 0, (long)256 * DM * 2, 4, 16, 64, G, c0};
            EpiStore E{out + O_PMK, (bf16_t*)(ws + WS_KB), DM, DM, (size_t)NB * NMEM * DM, 1.f, nullptr};
            gemm_phase(lds, Dims{DM, DM, DM}, S, E);
        }
        {
            GridSched S{(const char*)(ws + WS_WKV) + (size_t)DM * DM * 2, (const char*)(ws + WS_MEMB), (long)256 * DM * 2, 0, (long)256 * DM * 2, 8, 4, 32, G, (c0 + G - 64) % G};
            EpiStore E{nullptr, (bf16_t*)(ws + WS_VT), NB * NMEM, 0, 0, 1.f, nullptr};
            gemm_phase(lds, Dims{DM, DM, DM}, S, E);
        }
        {
            GridSched S{(const char*)(ws + WS_Z), (const char*)(ws + WS_WGLU), (long)256 * DSSM * 2, 0, (long)256 * DSSM * 2, MT / 256, 4, (MT / 256) * 4, G, (c0 + G - 96) % G};
            EpiGlu E{(const bf16_t*)(ws + WS_Z), argp()->in[21], (bf16_t*)(ws + WS_MIX)};
            gemm_phase(lds, Dims{DSSM, DSSM, DSSM}, S, E);
        }
        {
            GridSched S{(const char*)(ws + WS_POOLED), (const char*)(ws + WS_WPOOL), (long)256 * DPOOL * 2, (long)256 * 2, (long)256 * 256 * 2, MT / 256, 4, (MT / 256) * 4, G, (c0 + G - 96) % G};
            EpiStore E{nullptr, (bf16_t*)(ws + WS_MIX), DM, 0, 0, 1.f, argp()->in[11]};
            gemm_phase(lds, Dims{DPOOL, 256, 256}, S, E);
        }
    }
    SEAM(3);
    if (IN(4)) {
        GridSched S{(const char*)(ws + WS_MIX), (const char*)(ws + WS_WOUT), (long)256 * DM * 2, 0, (long)256 * DM * 2, MP / 256, DM / 256, (MP / 256) * (DM / 256), G, c0};
        EpiResid E{argp()->in[0], argp()->in[1], (float*)(ws + WS_PRE)};
        gemm_phase(lds, Dims{DM, DM, DM}, S, E);
        skinny_gemm(lds, (const bf16_t*)(ws + WS_MIX) + (size_t)MP * DM, DM, (const bf16_t*)(ws + WS_WOUT), DM, DM, SkResid{argp()->in[1], (float*)(ws + WS_PRE) + (size_t)MP * DM});
    }
    SEAM(4);
    if (IN(5)) { phase_ln<false>((const float*)(ws + WS_PRE), argp()->in[23], argp()->in[24], (float*)(ws + WS_H1), (bf16_t*)(ws + WS_HB)); }
    SEAM(5);
    if (IN(6)) {
        GridSched S{(const char*)(ws + WS_HB), (const char*)(ws + WS_WQ), (long)256 * DM * 2, 0, (long)256 * DM * 2, MP / 256, DM / 256, (MP / 256) * (DM / 256), G, c0};
        EpiStore E{nullptr, (bf16_t*)(ws + WS_Q), DM, 0, 0, QSCALE, nullptr};
        gemm_phase(lds, Dims{DM, DM, DM}, S, E);
        skinny_gemm(lds, (const bf16_t*)(ws + WS_HB) + (size_t)MP * DM, DM, (const bf16_t*)(ws + WS_WQ), DM, DM, SkStore{nullptr, (bf16_t*)(ws + WS_Q) + (size_t)MP * DM, QSCALE});
    }
    SEAM(6);
    if (IN(7)) {
        {
            SchedS S{(const char*)(ws + WS_Q), (const char*)(ws + WS_KB), G, c0};
            EpiStore E{(float*)(ws + WS_S), nullptr, NMEM, 0, 0, 1.f, nullptr};
            gemm_phase(lds, Dims{DM, DM, HD}, S, E);
        }
        phase_attn_sample(lds);
    }
    SEAM(7);
    if (IN(8)) { phase_softmax((const float*)(ws + WS_S), (bf16_t*)(ws + WS_P)); }
    SEAM(8);
    if (IN(9)) {
        SchedPV S{(const char*)(ws + WS_P), (const char*)(ws + WS_VT), G, c0};
        EpiStore E{nullptr, (bf16_t*)(ws + WS_AO), DM, 0, 0, 1.f, nullptr};
        gemm_phase(lds, Dims{NMEM, NB * NMEM, NMEM}, S, E);
    }
    SEAM(9);
    if (IN(10)) {
        GridSched S{(const char*)(ws + WS_AO), (const char*)(ws + WS_WO), (long)256 * DM * 2, 0, (long)256 * DM * 2, MP / 256, DM / 256, (MP / 256) * (DM / 256), G, c0};
        EpiResid E{(const float*)(ws + WS_H1), (const float*)(ws + WS_H1) + (size_t)MP * DM, (float*)(ws + WS_PRE)};
        gemm_phase(lds, Dims{DM, DM, DM}, S, E);
        skinny_gemm(lds, (const bf16_t*)(ws + WS_AO) + (size_t)MP * DM, DM, (const bf16_t*)(ws + WS_WO), DM, DM, SkResid{(const float*)(ws + WS_H1) + (size_t)MP * DM, (float*)(ws + WS_PRE) + (size_t)MP * DM});
    }
    SEAM(10);
    if (IN(11)) { phase_ln<false>((const float*)(ws + WS_PRE), argp()->in[29], argp()->in[30], (float*)(ws + WS_H2), (bf16_t*)(ws + WS_HB)); }
    SEAM(11);
    if (IN(12)) {
        GridSched S{(const char*)(ws + WS_HB), (const char*)(ws + WS_WGU), (long)256 * DM * 2, 0, (long)256 * DM * 2, MT / 256, 2 * DFF / 256, (MT / 256) * (2 * DFF / 256), G, c0};
        EpiGateUp E{(bf16_t*)(ws + WS_GU), out + O_PCONV, out + O_SCONV};
        gemm_phase(lds, Dims{DM, DM, DM}, S, E);
    }
    SEAM(12);
    if (IN(13)) { phase_act(); }
    SEAM(13);
    if (IN(14)) {
        GridSched S{(const char*)(ws + WS_ACT), (const char*)(ws + WS_WDOWN), (long)256 * DFF * 2, 0, (long)256 * DFF * 2, MP / 256, DM / 256, (MP / 256) * (DM / 256), G, c0};
        EpiResid E{(const float*)(ws + WS_H2), (const float*)(ws + WS_H2) + (size_t)MP * DM, (float*)(ws + WS_PRE)};
        gemm_phase(lds, Dims{DFF, DFF, DFF}, S, E);
        skinny_gemm(lds, (const bf16_t*)(ws + WS_ACT) + (size_t)MP * DFF, DFF, (const bf16_t*)(ws + WS_WDOWN), DFF, DFF, SkResid{(const float*)(ws + WS_H2) + (size_t)MP * DM, (float*)(ws + WS_PRE) + (size_t)MP * DM});
    }
    SEAM(14);
    if (IN(15)) { phase_ln<true>((const float*)(ws + WS_PRE), argp()->in[36], argp()->in[37], out + O_Y, nullptr); }
#undef IN
#undef SEAM
#undef out
}

extern "C" void kernel_launch(void* const* d_in, const int* in_sizes, int n_in, void* d_out, int out_size, void* d_ws, size_t ws_size, hipStream_t stream) {
    static int grid = 0;
    if (grid == 0) {
        if (n_in != 38 || (size_t)out_size != O_END || ws_size < WS_END) { fprintf(stderr, "kernel_launch: unexpected shapes: n_in %d out %d (want %zu) ws %zu (want %zu)\n", n_in, out_size, (size_t)O_END, ws_size, (size_t)WS_END); grid = -1; return; }
        int dev = 0, cus = 0, per_cu = 0;
        hipGetDevice(&dev);
        hipDeviceGetAttribute(&cus, hipDeviceAttributeMultiprocessorCount, dev);
        if (hipFuncSetAttribute((const void*)fwd_megakernel, hipFuncAttributeMaxDynamicSharedMemorySize, LDS_BYTES) != hipSuccess) { fprintf(stderr, "kernel_launch: hipFuncSetAttribute failed\n"); grid = -1; return; }
        if (hipOccupancyMaxActiveBlocksPerMultiprocessor(&per_cu, (const void*)fwd_megakernel, 512, LDS_BYTES) != hipSuccess || per_cu < 1) { fprintf(stderr, "kernel_launch: occupancy query says %d\n", per_cu); per_cu = 1; }
        (void)hipGetLastError();
        grid = cus * (per_cu > 1 ? 1 : per_cu);
        fprintf(stderr, "kernel_launch: grid %d (cus %d, per_cu %d)\n", grid, cus, per_cu);
    }
    if (grid < 0) return;
    Args a{};
    for (int i = 0; i < 38; ++i) a.in[i] = (const float*)d_in[i];
    a.out = (float*)d_out; a.ws = (unsigned char*)d_ws;
#if MK_PER_PHASE_LAUNCH
    for (int p = 0; p < N_PHASES; ++p) {
        a.ph_lo = p; a.ph_hi = p + 1;
        hipLaunchKernelGGL(fwd_megakernel, dim3(grid), dim3(512), LDS_BYTES, stream, a);
    }
#else
    a.ph_lo = 0; a.ph_hi = N_PHASES;
    if (hipMemsetAsync(d_ws, 0, 16384, stream) != hipSuccess) { fprintf(stderr, "kernel_launch: memset failed\n"); return; }
    void* kargs[] = {&a};
    hipError_t e = hipLaunchCooperativeKernel((const void*)fwd_megakernel, dim3(grid), dim3(512), kargs, LDS_BYTES, stream);
    if (e != hipSuccess) fprintf(stderr, "kernel_launch: cooperative launch failed: %s (grid %d)\n", hipGetErrorString(e), grid);
#endif
}
```
